# Optimizing an MI355X kernel written in HIP

```python
import math
import jax
import jax.numpy as jnp
from jax import lax
import numpy as np

D_MODEL = 2048
BATCH = 4
SEQ = 8192
DEPTH = 1

A_HEADS = 16
A_QK_DIM = 128
A_V_DIM = 64
A_Q_RANK = 512
A_KV_RANK = 128
IDX_HEADS = 16
IDX_DIM = 64
IDX_TOPK = 256
Q_BLOCK = 128
RPB_BUCKETS = 32
RPB_MAX_DIST = 128
B_HEADS = 8
B_KEY_DIM = 128
B_VAL_DIM = 128
B_CHUNK = 64
N_EXPERTS = 64
EXPERT_DIM = 512
MOE_TOPK = 8
N_GROUPS = 8
TOPK_GROUPS = 4
ROUTED_SCALE = 2.5
EXPERT_BLOCK = 256
DN_ALPHA = (2 * DEPTH) ** 0.25
DN_BETA = (8 * DEPTH) ** -0.25
EPS = 1e-6

IN_SPLITS = (A_Q_RANK, A_KV_RANK, IDX_DIM, IDX_HEADS,
             B_HEADS * B_KEY_DIM, B_HEADS * B_KEY_DIM, B_HEADS * B_VAL_DIM, B_HEADS * B_VAL_DIM,
             D_MODEL, D_MODEL)
IN_WIDTH = sum(IN_SPLITS)

kernel_name = 'hybrid_dsa_hgrn2_moe_deepnorm_block'


def _layer_norm(x, g=None, b=None):
    xf = x.astype(jnp.float32)
    mu = jnp.mean(xf, -1, keepdims=True)
    var = jnp.mean(jnp.square(xf - mu), -1, keepdims=True)
    y = (xf - mu) * lax.rsqrt(var + EPS)
    if g is not None:
        y = y * g.astype(jnp.float32) + b.astype(jnp.float32)
    return y.astype(x.dtype)


def _rms_norm(x, g):
    xf = x.astype(jnp.float32)
    y = xf * lax.rsqrt(jnp.mean(jnp.square(xf), -1, keepdims=True) + EPS)
    return (y * g.astype(jnp.float32)).astype(x.dtype)


def _swiglu(h, w_gate, w_up, w_down):
    return (jax.nn.silu(h @ w_gate) * (h @ w_up)) @ w_down


def _t5_bucket(dist):
    max_exact = RPB_BUCKETS // 2
    d = jnp.maximum(dist, 1).astype(jnp.float32)
    large = max_exact + (jnp.log(d / max_exact) / math.log(RPB_MAX_DIST / max_exact)
                         * (RPB_BUCKETS - max_exact)).astype(jnp.int32)
    large = jnp.minimum(large, RPB_BUCKETS - 1)
    return jnp.where(dist < max_exact, dist, large)


def _dsa_attention(q_lat, q_idx, w_idx, k_idx, kv_lat, rpb_table):
    B, S, H, C = q_lat.shape
    topk = min(IDX_TOPK, S // 4)
    nb = S // Q_BLOCK
    key_pos = jnp.arange(S)

    def blocks(a):
        return jnp.moveaxis(a.reshape((B, nb, Q_BLOCK) + a.shape[2:]), 1, 0)

    def one_block(inp):
        ql, qi, wi, start = inp
        t = start + jnp.arange(Q_BLOCK)
        rel = jax.nn.relu(jnp.einsum('bqhd,bsd->bqhs', qi, k_idx).astype(jnp.float32))
        score = jnp.einsum('bqh,bqhs->bqs', wi.astype(jnp.float32), rel)
        score = jnp.where(key_pos[None, None, :] <= t[None, :, None], score, -jnp.inf)
        _, sel = lax.top_k(score, topk)
        valid = sel <= t[None, :, None]
        kv_sel = jax.vmap(lambda kv, ix: kv[ix])(kv_lat, sel)
        bias = rpb_table[_t5_bucket(jnp.maximum(t[None, :, None] - sel, 0))]
        logits = (jnp.einsum('bqhc,bqkc->bqhk', ql, kv_sel).astype(jnp.float32) * A_QK_DIM ** -0.5
                  + jnp.moveaxis(bias, -1, 2).astype(jnp.float32))
        logits = jnp.where(valid[:, :, None, :], logits, -jnp.inf)
        p = jax.nn.softmax(logits, axis=-1).astype(kv_sel.dtype)
        return jnp.einsum('bqhk,bqkc->bqhc', p, kv_sel)

    out = lax.map(one_block, (blocks(q_lat), blocks(q_idx), blocks(w_idx),
                              jnp.arange(nb, dtype=jnp.int32) * Q_BLOCK))
    return jnp.moveaxis(out, 0, 1).reshape(B, S, H, C)


def _hgrn2_chunked(q, k, v, log_f):
    B, S, H, dk = q.shape
    dv = v.shape[-1]
    nc = S // B_CHUNK

    def to_chunks(a):
        return a.astype(jnp.float32).reshape(B, nc, B_CHUNK, H, a.shape[-1]).transpose(1, 0, 3, 2, 4)

    causal = jnp.tril(jnp.ones((B_CHUNK, B_CHUNK), bool))

    def step(state, inp):
        qc, kc, vc, lfc = inp
        b = jnp.cumsum(lfc, axis=2)
        o_inter = jnp.einsum('bhtk,bhkv->bhtv', qc * jnp.exp(b), state)
        diff = b[:, :, :, None, :] - b[:, :, None, :, :]
        decay = jnp.exp(jnp.where(causal[:, :, None], diff, -jnp.inf))
        att = jnp.einsum('bhtk,bhsk,bhtsk->bhts', qc, kc, decay)
        o = o_inter + jnp.einsum('bhts,bhsv->bhtv', att, vc)
        b_last = b[:, :, -1:, :]
        k_dec = kc * jnp.exp(b_last - b)
        state = (jnp.exp(b_last[:, :, 0, :])[..., None] * state
                 + jnp.einsum('bhsk,bhsv->bhkv', k_dec, vc))
        return state, o

    state0 = jnp.zeros((B, H, dk, dv), jnp.float32)
    _, o = lax.scan(step, state0, (to_chunks(q), to_chunks(k), to_chunks(v), to_chunks(log_f)))
    return o.transpose(1, 0, 3, 2, 4).reshape(B, S, H, dv)


def _routed_experts(h, w_router, router_bias, w_gate, w_up, w_down):
    n_tok, d = h.shape
    scores = jax.nn.sigmoid((h @ w_router).astype(jnp.float32))
    biased = scores + router_bias.astype(jnp.float32)
    per_group = N_EXPERTS // N_GROUPS
    group_score = lax.top_k(biased.reshape(n_tok, N_GROUPS, per_group), 2)[0].sum(-1)
    _, top_groups = lax.top_k(group_score, TOPK_GROUPS)
    group_mask = jnp.any(top_groups[..., None] == jnp.arange(N_GROUPS), axis=-2)
    expert_mask = jnp.repeat(group_mask, per_group, axis=-1)
    _, sel = lax.top_k(jnp.where(expert_mask, biased, -jnp.inf), MOE_TOPK)
    wts = jnp.take_along_axis(scores, sel, axis=-1)
    wts = wts / jnp.sum(wts, -1, keepdims=True) * ROUTED_SCALE
    n_assign = n_tok * MOE_TOPK
    e_flat = sel.reshape(n_assign)
    order = jnp.argsort(e_flat)
    e_sorted = e_flat[order]
    tok_sorted = (order // MOE_TOPK).astype(jnp.int32)
    w_sorted = wts.reshape(n_assign)[order].astype(h.dtype)
    sizes = jax.ops.segment_sum(jnp.ones((n_assign,), jnp.int32), e_flat, num_segments=N_EXPERTS)
    padded = (sizes + EXPERT_BLOCK - 1) // EXPERT_BLOCK * EXPERT_BLOCK
    start = jnp.cumsum(sizes) - sizes
    pend = jnp.cumsum(padded)
    pstart = pend - padded
    dest = pstart[e_sorted] + jnp.arange(n_assign, dtype=jnp.int32) - start[e_sorted]
    n_rows = -(-(n_assign + N_EXPERTS * (EXPERT_BLOCK - 1)) // EXPERT_BLOCK) * EXPERT_BLOCK
    n_blocks = n_rows // EXPERT_BLOCK
    tok_buf = jnp.zeros((n_rows,), jnp.int32).at[dest].set(tok_sorted)
    w_buf = jnp.zeros((n_rows,), h.dtype).at[dest].set(w_sorted)
    blk_expert = jnp.minimum(
        jnp.searchsorted(pend, jnp.arange(n_blocks, dtype=jnp.int32) * EXPERT_BLOCK, side='right'),
        N_EXPERTS - 1)

    def accumulate(acc, inp):
        tok, wt, e = inp
        y = _swiglu(h[tok], w_gate[e], w_up[e], w_down[e])
        return acc.at[tok].add(y * wt[:, None]), None

    out, _ = lax.scan(accumulate, jnp.zeros_like(h),
                      (tok_buf.reshape(n_blocks, EXPERT_BLOCK), w_buf.reshape(n_blocks, EXPERT_BLOCK), blk_expert))
    return out


def setup_inputs(seed: int = 0) -> dict:
    key = jax.random.key(seed)
    ks = jax.random.split(key, 40)
    D = D_MODEL
    L = DEPTH

    def nrm(i, shape, scale):
        return jax.random.normal(ks[i], shape, jnp.float32) * scale

    return {
        'x': nrm(0, (BATCH, SEQ, D), 1.0),
        'c': nrm(1, (BATCH, D), 1.0),
        'rpb_table': nrm(2, (RPB_BUCKETS, A_HEADS), 0.5),
        'hgrn_lb_logits': nrm(3, (DEPTH + 1, B_HEADS * B_KEY_DIM), 0.5),
        'ada_w': nrm(4, (L, D, 6 * D), D ** -0.5),
        'ada_b': nrm(5, (L, 6 * D), 0.02),
        'w_in': nrm(6, (L, D, IN_WIDTH), D ** -0.5),
        'q_norm_g': 1.0 + nrm(7, (L, A_Q_RANK), 0.02),
        'kv_norm_g': 1.0 + nrm(8, (L, A_KV_RANK), 0.02),
        'w_uq': nrm(9, (L, A_Q_RANK, A_HEADS * A_QK_DIM), A_Q_RANK ** -0.5),
        'w_uk': nrm(10, (L, A_HEADS, A_KV_RANK, A_QK_DIM), A_KV_RANK ** -0.5),
        'w_uv': nrm(11, (L, A_HEADS, A_KV_RANK, A_V_DIM), DN_BETA * A_KV_RANK ** -0.5),
        'w_qidx': nrm(12, (L, A_Q_RANK, IDX_HEADS * IDX_DIM), A_Q_RANK ** -0.5),
        'idx_k_norm_g': 1.0 + nrm(13, (L, IDX_DIM), 0.02),
        'idx_k_norm_b': nrm(14, (L, IDX_DIM), 0.02),
        'hgrn_out_norm_g': 1.0 + nrm(15, (L, B_VAL_DIM), 0.02),
        'w_branch_a': nrm(16, (L, A_HEADS * A_V_DIM, D), (A_HEADS * A_V_DIM) ** -0.5),
        'w_branch_b': nrm(17, (L, B_HEADS * B_VAL_DIM, D), (B_HEADS * B_VAL_DIM) ** -0.5),
        'w_o': nrm(18, (L, D, D), DN_BETA * D ** -0.5),
        'ln1_g': 1.0 + nrm(19, (L, D), 0.02),
        'ln1_b': nrm(20, (L, D), 0.02),
        'w_router': nrm(21, (L, D, N_EXPERTS), D ** -0.5),
        'router_bias': nrm(22, (L, N_EXPERTS), 0.01),
        'w_exp_gate': nrm(23, (L, N_EXPERTS, D, EXPERT_DIM), D ** -0.5),
        'w_exp_up': nrm(24, (L, N_EXPERTS, D, EXPERT_DIM), D ** -0.5),
        'w_exp_down': nrm(25, (L, N_EXPERTS, EXPERT_DIM, D), DN_BETA * EXPERT_DIM ** -0.5),
        'w_sh_gate': nrm(26, (L, D, EXPERT_DIM), D ** -0.5),
        'w_sh_up': nrm(27, (L, D, EXPERT_DIM), D ** -0.5),
        'w_sh_down': nrm(28, (L, EXPERT_DIM, D), DN_BETA * EXPERT_DIM ** -0.5),
        'ln2_g': 1.0 + nrm(29, (L, D), 0.02),
        'ln2_b': nrm(30, (L, D), 0.02),
    }


def reference(x, c, rpb_table, hgrn_lb_logits, ada_w, ada_b, w_in, q_norm_g, kv_norm_g,
              w_uq, w_uk, w_uv, w_qidx, idx_k_norm_g, idx_k_norm_b, hgrn_out_norm_g,
              w_branch_a, w_branch_b, w_o, ln1_g, ln1_b, w_router, router_bias,
              w_exp_gate, w_exp_up, w_exp_down, w_sh_gate, w_sh_up, w_sh_down, ln2_g, ln2_b):
    B, S, D = x.shape
    lower_bounds = jnp.cumsum(jax.nn.softmax(hgrn_lb_logits.astype(jnp.float32), axis=0), axis=0)
    cond = jax.nn.silu(c)
    split_at = np.cumsum(IN_SPLITS)[:-1].tolist()
    for l in range(DEPTH):
        mod = (cond @ ada_w[l] + ada_b[l])[:, None, :]
        shift1, scale1, gate1, shift2, scale2, gate2 = jnp.split(mod, 6, axis=-1)

        h = _layer_norm(x) * (1 + scale1) + shift1
        proj = h @ w_in[l]
        c_q, c_kv, k_i, w_i, hq, hf, hi, hg, ga, gb = jnp.split(proj, split_at, axis=-1)

        c_q = _rms_norm(c_q, q_norm_g[l])
        q = (c_q @ w_uq[l]).reshape(B, S, A_HEADS, A_QK_DIM)
        q_lat = jnp.einsum('bshd,hcd->bshc', q, w_uk[l])
        q_idx = (c_q @ w_qidx[l]).reshape(B, S, IDX_HEADS, IDX_DIM)
        k_idx = _layer_norm(k_i, idx_k_norm_g[l], idx_k_norm_b[l])
        w_idx = w_i * (IDX_HEADS * IDX_DIM) ** -0.5
        kv_lat = _rms_norm(c_kv, kv_norm_g[l])
        o_lat = _dsa_attention(q_lat, q_idx, w_idx, k_idx, kv_lat, rpb_table)
        y_a = jnp.einsum('bshc,hcv->bshv', o_lat, w_uv[l]).reshape(B, S, A_HEADS * A_V_DIM) @ w_branch_a[l]

        lb = lower_bounds[l].reshape(B_HEADS, B_KEY_DIM)
        f = lb + (1 - lb) * jax.nn.sigmoid(hf.reshape(B, S, B_HEADS, B_KEY_DIM).astype(jnp.float32))
        q_b = jax.nn.silu(hq).reshape(B, S, B_HEADS, B_KEY_DIM) * B_KEY_DIM ** -0.5
        o_b = _hgrn2_chunked(q_b, 1 - f, hi.reshape(B, S, B_HEADS, B_VAL_DIM), jnp.log(f)).astype(x.dtype)
        o_b = _rms_norm(o_b, hgrn_out_norm_g[l]) * jax.nn.silu(hg.reshape(B, S, B_HEADS, B_VAL_DIM))
        y_b = o_b.reshape(B, S, B_HEADS * B_VAL_DIM) @ w_branch_b[l]

        mixed = (jax.nn.sigmoid(ga) * y_a + jax.nn.sigmoid(gb) * y_b) @ w_o[l]
        x = _layer_norm(DN_ALPHA * x + gate1 * mixed, ln1_g[l], ln1_b[l])

        h2 = (_layer_norm(x) * (1 + scale2) + shift2).reshape(B * S, D)
        y = (_swiglu(h2, w_sh_gate[l], w_sh_up[l], w_sh_down[l])
             + _routed_experts(h2, w_router[l], router_bias[l], w_exp_gate[l], w_exp_up[l], w_exp_down[l]))
        x = _layer_norm(DN_ALPHA * x + gate2 * y.reshape(B, S, D), ln2_g[l], ln2_b[l])
    return x
```

```cpp
#include <hip/hip_runtime.h>
#include <stdint.h>
#include <string.h>

#ifndef PROBE
#define PROBE 0
#endif
#define LAS __attribute__((address_space(3)))
typedef unsigned short u16;
typedef unsigned short bf16_t;
typedef short bf16x8 __attribute__((ext_vector_type(8)));
typedef short s16x4 __attribute__((ext_vector_type(4)));
typedef float f32x4 __attribute__((ext_vector_type(4)));
typedef float f32x2 __attribute__((ext_vector_type(2)));
typedef unsigned u32x4 __attribute__((ext_vector_type(4)));
typedef unsigned u32x2 __attribute__((ext_vector_type(2)));
typedef unsigned char LAS* ldsp_t;

constexpr int D = 2048, NB = 4, SEQ = 8192, NT = NB * SEQ;
constexpr int IN_W = 8912, IN_WP = 8960;
constexpr int NEXP = 64, EDIM = 512, NE1 = 65;
constexpr int TOPK = 256;
constexpr float DN_ALPHA = 1.189207115002721f;
constexpr float LN_EPS = 1e-6f;
constexpr int NTHREADS = 512;
constexpr int LDS_BYTES = 160 * 1024;
constexpr int NCHUNK = 2, CHTOK = NT / NCHUNK;
constexpr int MAXTILES = NT * 8 / 256 / NCHUNK + 64 + CHTOK / 256;
constexpr int MAXSLOTS = MAXTILES * 256;
constexpr int HSEG = 8, HSEGL = SEQ / HSEG;

constexpr size_t MB = 1u << 20;
constexpr size_t al(size_t x) { return (x + 255) & ~(size_t)255; }
constexpr size_t O_BAR = 0;
constexpr size_t O_CNT = 16384;
constexpr size_t O_ZERO_BYTES = 16384 + 4096;
constexpr size_t O_MOD = O_ZERO_BYTES;
constexpr size_t O_LB = O_MOD + al((size_t)4 * 12288 * 4);
constexpr size_t O_TSTART = O_LB + 4096;
constexpr size_t O_TILEE = O_TSTART + 2048;
constexpr size_t O_BTR = al(O_TILEE + NCHUNK * MAXTILES * 4 + 4096);
constexpr size_t O_BTIN = O_BTR + (size_t)256 * 2048 * 2;
constexpr size_t O_BTIN8 = O_BTIN + (size_t)768 * 2048 * 2;
constexpr size_t O_BTQ = O_BTIN8 + (size_t)8192 * 2048;
constexpr size_t O_BTAB = O_BTQ + (size_t)3072 * 512 * 2;
constexpr size_t O_BTBB = O_BTAB + (size_t)2048 * 2048 * 2;
constexpr size_t O_BTO = O_BTBB + (size_t)2048 * 1024 * 2;
constexpr size_t O_SMALL_END = O_BTO + (size_t)2048 * 2048 * 2;
constexpr size_t O_B = al(O_SMALL_END);
constexpr size_t O_PSM = O_B;
constexpr size_t O_QB = O_PSM + (size_t)NT * 768 * 2;
constexpr size_t O_LF = O_QB + (size_t)NT * 1024 * 2;
constexpr size_t O_V = O_LF + (size_t)NT * 1024 * 2;
constexpr size_t O_G = O_V + (size_t)NT * 1024 * 2;
constexpr size_t O_SGA = O_G + (size_t)NT * 1024 * 2;
constexpr size_t O_SGB = O_SGA + (size_t)NT * 2048 * 2;
constexpr size_t O_B_END = O_SGB + (size_t)NT * 2048 * 2;
constexpr size_t O_H2 = O_BTIN;
constexpr size_t O_H28 = O_H2 + (size_t)NT * 2048 * 2;
constexpr size_t O_HH = O_H28 + (size_t)NT * 2048;
constexpr size_t O_R16 = O_HH;
constexpr size_t HH_BYTES = (size_t)MAXSLOTS * 512 > (size_t)NT * 2048 * 2 ? (size_t)MAXSLOTS * 512 : (size_t)NT * 2048 * 2;
constexpr size_t O_Y = al(O_HH + HH_BYTES);
constexpr size_t O_LOGIT = O_Y + (size_t)CHTOK * 8 * 2048;
constexpr size_t O_RSEL = O_LOGIT + (size_t)NT * 64 * 4;
constexpr size_t O_RW = O_RSEL + (size_t)NT * 8 * 4;
constexpr size_t O_TOKOF = O_RW + (size_t)NT * 8 * 4;
constexpr size_t O_WOF = O_TOKOF + (size_t)NCHUNK * MAXSLOTS * 4;
constexpr size_t O_DSTOF = O_WOF + (size_t)NCHUNK * MAXSLOTS * 4;
constexpr size_t O_BTGU = al(O_DSTOF + (size_t)NCHUNK * MAXSLOTS * 4);
constexpr size_t O_BTD = O_BTGU + (size_t)NE1 * 1024 * 2048;
constexpr size_t O_END2 = O_BTD + (size_t)NE1 * 2048 * 512;
constexpr size_t O_T16 = al(O_END2);
constexpr size_t O_END3 = O_T16 + (size_t)NT * 2048 * 2;
static_assert(O_END3 <= (size_t)1270 * 1000 * 1000, "workspace budget (MoE time)");
constexpr size_t O_A = al(O_B_END);
constexpr size_t O_HN = O_A;
constexpr size_t O_QLAT = O_A;
constexpr size_t O_MIX = O_A;
constexpr size_t O_C = O_A + (size_t)NT * 2048 * 2;
constexpr size_t O_CQN = O_C;
constexpr size_t O_KV = O_CQN + (size_t)NT * 512 * 2;
constexpr size_t O_KIDX = O_KV + (size_t)NT * 128 * 2;
constexpr size_t O_WIDX = O_KIDX + (size_t)NT * 64 * 2;
constexpr size_t O_QIDX = O_WIDX + (size_t)NT * 16 * 4;
constexpr size_t O_SEL = O_QIDX + (size_t)NT * 1024 * 2;
constexpr size_t O_OLAT = O_SEL + (size_t)NT * 256 * 2;
constexpr size_t O_OB = O_OLAT + (size_t)NT * 2048 * 2;
constexpr size_t O_HST = O_OB + (size_t)NT * 1024 * 2;
constexpr size_t O_HDEC = O_HST + (size_t)256 * 128 * 128 * 4;
constexpr size_t O_END1 = O_HDEC + (size_t)256 * 128 * 4;
constexpr size_t O_H8 = al(O_END1);
constexpr size_t O_END1B = O_H8 + (size_t)NT * 2048;
static_assert(O_END1B <= (size_t)1270 * 1000 * 1000, "workspace budget");

struct Params {
    const float *x, *c, *rpb, *lbl, *ada_w, *ada_b, *w_in, *qng, *kvng, *w_uq, *w_uk, *w_uv, *w_qidx, *ikg, *ikb, *hong,
        *w_ba, *w_bb, *w_o, *ln1g, *ln1b, *w_router, *rbias, *w_eg, *w_eu, *w_ed, *w_sg, *w_su, *w_sd, *ln2g, *ln2b;
    float* out;
    unsigned char* ws;
    int rep[20];
};

__device__ __forceinline__ float bf2f(unsigned short b) { return __uint_as_float(((unsigned)b) << 16); }
__device__ __forceinline__ unsigned short f2bf(float f) { unsigned u = __float_as_uint(f); u += 0x7FFFu + ((u >> 16) & 1u); return (unsigned short)(u >> 16); }
__device__ __forceinline__ unsigned pk_bf16(float lo, float hi) { unsigned r; asm volatile("v_cvt_pk_bf16_f32 %0, %1, %2" : "=v"(r) : "v"(lo), "v"(hi)); return r; }
__device__ __forceinline__ float sigmoidf_(float v) { return __builtin_amdgcn_rcpf(1.0f + __expf(-v)); }
__device__ __forceinline__ float siluf_(float v) { return v * __builtin_amdgcn_rcpf(1.0f + __expf(-v)); }
#define DPPF(v, ctrl) __int_as_float(__builtin_amdgcn_update_dpp(0, __float_as_int(v), ctrl, 0xf, 0xf, false))
__device__ __forceinline__ float wave_sum(float v) {
    v += DPPF(v, 0xB1); v += DPPF(v, 0x4E); v += DPPF(v, 0x141); v += DPPF(v, 0x140);
    u32x2 r = __builtin_amdgcn_permlane16_swap(__float_as_uint(v), __float_as_uint(v), false, false); v = __uint_as_float(r[0]) + __uint_as_float(r[1]);
    r = __builtin_amdgcn_permlane32_swap(__float_as_uint(v), __float_as_uint(v), false, false); v = __uint_as_float(r[0]) + __uint_as_float(r[1]);
    return v;
}
__device__ __forceinline__ int wave_sum_i(int v) {
#pragma unroll
    for (int o = 32; o >= 1; o >>= 1) v += __shfl_xor(v, o);
    return v;
}
__device__ __forceinline__ int opaque_tid() { int t = threadIdx.x; asm volatile("" : "+v"(t)); return t; }
constexpr float OSCALE = 8.0f, MSCALE = 4.0f;
__device__ __forceinline__ unsigned char f2fp8(float v) { return (unsigned char)(__builtin_amdgcn_cvt_pk_fp8_f32(v, v, 0, false) & 0xff); }
constexpr float YSCALE = 16.0f;
__device__ __forceinline__ u32x2 pk8_fp8(const f32x4& v0, const f32x4& v1) {
    int lo = 0, hi = 0;
    lo = __builtin_amdgcn_cvt_pk_fp8_f32(v0[0], v0[1], lo, false); lo = __builtin_amdgcn_cvt_pk_fp8_f32(v0[2], v0[3], lo, true);
    hi = __builtin_amdgcn_cvt_pk_fp8_f32(v1[0], v1[1], hi, false); hi = __builtin_amdgcn_cvt_pk_fp8_f32(v1[2], v1[3], hi, true);
    return (u32x2){(unsigned)lo, (unsigned)hi}; }
#define XB_TMO      128
#define XB_XCNT(j)  (256  + 64 * (j))
#define XB_XSUB(j)  (1280 + 64 * (j))
#define XB_XGEN(j)  (2304 + 64 * (j))
#define XB_TOP      3328
#define XB_TOPGEN   3392
#define XCD_BAR_WORDS 3456
#define XB_SPIN_CAP (1u << 18)

__device__ __forceinline__ unsigned xb_ld(unsigned* p)              { return __hip_atomic_load(p, __ATOMIC_RELAXED, __HIP_MEMORY_SCOPE_AGENT); }
__device__ __forceinline__ unsigned xb_add(unsigned* p, unsigned v) { return __hip_atomic_fetch_add(p, v, __ATOMIC_RELAXED, __HIP_MEMORY_SCOPE_AGENT); }
__device__ __forceinline__ unsigned xb_xcc_id() { return (unsigned)__builtin_amdgcn_s_getreg((3 << 11) | 20) & 0xFu; }
#define XB_SPIN(cond, bar) do { unsigned _sp = 0; while (cond) { __builtin_amdgcn_s_sleep(1); \
    if ((++_sp & 255u) == 0u) { if (xb_ld(&(bar)[XB_TMO])) break; if (_sp > XB_SPIN_CAP) { atomicAdd(&(bar)[XB_TMO], 1u); break; } } } } while (0)

struct XcdBarrier {
    unsigned* bar; unsigned x;
    volatile LAS unsigned* st;
};

__device__ __forceinline__ XcdBarrier xcd_barrier_post(unsigned* bar, volatile LAS unsigned* st) {
    XcdBarrier b; b.bar = bar; b.x = xb_xcc_id(); b.st = st;
    if (threadIdx.x == 0) (void)xb_add(&bar[XB_XCNT(b.x)], 1u);
    return b;
}
__device__ __forceinline__ void xcd_barrier_complete(unsigned* bar, unsigned x, unsigned& nloc, unsigned& nx) {
    const unsigned G = gridDim.x * gridDim.y * gridDim.z;
    unsigned sum, cnt, mine, sp = 0u;
    for (;;) {
        sum = 0u; cnt = 0u; mine = 0u;
#pragma unroll
        for (unsigned j = 0; j < 16; ++j) { const unsigned c = xb_ld(&bar[XB_XCNT(j)]); sum += c; cnt += (c > 0u) ? 1u : 0u; mine = (j == x) ? c : mine; }
        if (sum == G) break;
        __builtin_amdgcn_s_sleep(1);
        if ((++sp & 255u) == 0u) { if (xb_ld(&bar[XB_TMO])) break; if (sp > XB_SPIN_CAP) { atomicAdd(&bar[XB_TMO], 1u); break; } }
    }
    nloc = mine > 0u ? mine : 1u; nx = cnt > 0u ? cnt : 1u;
}

__device__ __forceinline__ void xcd_barrier(const XcdBarrier& b) {
    asm volatile("s_waitcnt vmcnt(0)" ::: "memory");
    __syncthreads();
    if (threadIdx.x == 0) {
        unsigned* bar = b.bar;
        __builtin_amdgcn_s_waitcnt(0);
        unsigned nloc = b.st[0], nx = b.st[1];
        if (nloc == 0u) { xcd_barrier_complete(bar, b.x, nloc, nx); b.st[0] = nloc; b.st[1] = nx; }
        const unsigned old = xb_add(&bar[XB_XSUB(b.x)], 1u);
        const unsigned gen = old / nloc;
        if (old + 1u == (gen + 1u) * nloc) {
            __builtin_amdgcn_fence(__ATOMIC_RELEASE, "agent");
            asm volatile("s_waitcnt vmcnt(0)" ::: "memory");
            const unsigned og = xb_add(&bar[XB_TOP], 1u);
            const unsigned tg = og / nx;
            if (og + 1u == (tg + 1u) * nx) xb_add(&bar[XB_TOPGEN], 1u);
            else XB_SPIN(xb_ld(&bar[XB_TOPGEN]) == tg, bar);
            __builtin_amdgcn_fence(__ATOMIC_ACQUIRE, "agent");
            xb_add(&bar[XB_XGEN(b.x)], 1u);
            asm volatile("s_waitcnt vmcnt(0)" ::: "memory");
        } else {
            XB_SPIN(xb_ld(&bar[XB_XGEN(b.x)]) == gen, bar);
            __builtin_amdgcn_fence(__ATOMIC_ACQUIRE, "agent");
            asm volatile("s_waitcnt vmcnt(0)" ::: "memory");
        }
    }
    __syncthreads();
}
namespace gm {
typedef int i32x4_t __attribute__((ext_vector_type(4)));
typedef int i32x8_t __attribute__((ext_vector_type(8)));
constexpr int BM = 256, BK = 64, HALF = 128, HTB = HALF * BK * 2, STAGE_BYTES = 8 * HTB;
__host__ __device__ __forceinline__ int lds_byte(int r, int c) { const int st = (r >> 4) * 2 + (c >> 5), rr = r & 15, cc = c & 31, ob = rr * 64 + cc * 2; return st * 1024 + (ob ^ (((ob >> 9) & 1) << 5)); }
__host__ __device__ __forceinline__ void stage_rc(int b, int& R, int& C) { const int st = b / 1024, sb = b % 1024, swz = sb ^ (((sb >> 9) & 1) << 5); R = (st >> 1) * 16 + swz / 64; C = (st & 1) * 32 + (swz % 64) / 2; }
__host__ __device__ __forceinline__ int perm32(int rho) { const int n = rho >> 4, i = rho & 15; return 8 * (i >> 2) + 4 * n + (i & 3); }

struct Unit { int pm, pn, e; };

template <class Epi, class Sched>
__device__ __forceinline__ void gemm_phase(ldsp_t lds, const Sched& S, const Epi& E, const int K) {
    const int tid = opaque_tid(), wid = __builtin_amdgcn_readfirstlane(tid >> 6), lane = tid & 63, wr = wid >> 2, wc = wid & 3, fr = lane & 15, fq = lane >> 4;
    const int nt = K / BK;
    int Rr[2], Cc[2];
    unsigned voffB[2], voffA[2][2], nvoffA[2][2];
#pragma unroll
    for (int i = 0; i < 2; ++i) { stage_rc(tid * 16 + i * 8192, Rr[i], Cc[i]); const int Rb = Epi::PERM ? ((Rr[i] & ~31) + perm32(Rr[i] & 31)) : Rr[i];
        voffB[i] = (unsigned)(Rb * S.ldb + Cc[i]) * 2u; }
    const size_t kstep = (size_t)(BK * 2);
    const size_t hstepB = (size_t)HALF * S.ldb * 2;
    const unsigned ldsw = (unsigned)wid * 1024u;
    const int aoff = lds_byte(wr * 64 + fr, fq * 8), boff = lds_byte(wc * 32 + fr, fq * 8);
#define G_SA(b, h) (((b) * 2 + (h)) * HTB)
#define G_SB(b, h) ((4 + (b) * 2 + (h)) * HTB)
#define G_STAGE_B(bufoff, gbase) do { _Pragma("unroll") for (int _i = 0; _i < 2; ++_i) \
        __builtin_amdgcn_global_load_lds((const unsigned*)((const char*)(gbase) + voffB[_i]), (LAS unsigned*)(lds + (bufoff) + ldsw + _i * 8192), 16, 0, 0); } while (0)
#define G_STAGE_A(bufoff, gbase, vo, h) do { _Pragma("unroll") for (int _i = 0; _i < 2; ++_i) \
        __builtin_amdgcn_global_load_lds((const unsigned*)((const char*)(gbase) + (vo)[h][_i]), (LAS unsigned*)(lds + (bufoff) + ldsw + _i * 8192), 16, 0, 0); } while (0)
#define G_LD8(base_) __builtin_shufflevector(*(const LAS i32x4_t*)(base_), *(const LAS i32x4_t*)((base_) + 1024), 0, 1, 2, 3, 4, 5, 6, 7)
#define G_LDA(dst, b, h) do { if constexpr (Epi::FP8) { _Pragma("unroll") for (int m = 0; m < 4; ++m) dst##8[m] = G_LD8(lds + G_SA(b, h) + aoff + m * 2048); } \
        else { _Pragma("unroll") for (int m = 0; m < 4; ++m) _Pragma("unroll") for (int k = 0; k < 2; ++k) dst[m][k] = *(const LAS bf16x8*)(lds + G_SA(b, h) + aoff + m * 2048 + k * 1024); } } while (0)
#define G_LDB(dst, b, h) do { if constexpr (Epi::FP8) { _Pragma("unroll") for (int n = 0; n < 2; ++n) dst##8[n] = G_LD8(lds + G_SB(b, h) + boff + n * 2048); } \
        else { _Pragma("unroll") for (int n = 0; n < 2; ++n) _Pragma("unroll") for (int k = 0; k < 2; ++k) dst[n][k] = *(const LAS bf16x8*)(lds + G_SB(b, h) + boff + n * 2048 + k * 1024); } } while (0)
#define G_MMA(ai, bj, At, Bt) do { __builtin_amdgcn_s_setprio(1); \
        if constexpr (Epi::FP8) { _Pragma("unroll") for (int m = 0; m < 4; ++m) _Pragma("unroll") for (int n = 0; n < 2; ++n) \
            asm volatile("v_mfma_scale_f32_16x16x128_f8f6f4 %0, %1, %2, %0, %3, %3 op_sel_hi:[0,0,0]" : "+v"(acc[ai][bj][m][n]) : "v"(Bt##8[n]), "v"(At##8[m]), "v"(sc_one)); } \
        else { _Pragma("unroll") for (int m = 0; m < 4; ++m) _Pragma("unroll") for (int n = 0; n < 2; ++n) _Pragma("unroll") for (int k = 0; k < 2; ++k) \
            acc[ai][bj][m][n] = __builtin_amdgcn_mfma_f32_16x16x32_bf16(Bt[n][k], At[m][k], acc[ai][bj][m][n], 0, 0, 0); } \
        __builtin_amdgcn_s_setprio(0); } while (0)
#define G_WAIT_V(n) asm volatile("s_waitcnt vmcnt(" #n ")" ::: "memory")
#define G_WAIT_L(n) asm volatile("s_waitcnt lgkmcnt(" #n ")" ::: "memory")
#define G_BAR __builtin_amdgcn_s_barrier()
#define G_SCHED __builtin_amdgcn_sched_barrier(0)
    Unit cur, nxt; int ui = 0;
    if (!S.next(0, cur)) return;
    f32x4 acc[2][2][4][2];
#pragma unroll
    for (int a = 0; a < 2; ++a)
#pragma unroll
        for (int b = 0; b < 2; ++b)
#pragma unroll
            for (int m = 0; m < 4; ++m)
#pragma unroll
                for (int n = 0; n < 2; ++n) acc[a][b][m][n] = (f32x4){0.f, 0.f, 0.f, 0.f};
    const int sc_one = 0x7f7f7f7f; (void)sc_one;
    bf16x8 At[4][2], B0[2][2], B1[2][2]; i32x8_t At8[4], B08[2], B18[2];
    const char* cA = S.a_base(cur); const char* cB = S.b_base(cur);
#pragma unroll
    for (int h = 0; h < 2; ++h)
#pragma unroll
        for (int i = 0; i < 2; ++i) {
            if constexpr (Sched::GATHER) voffA[h][i] = S.a_row_off(cur, h * HALF + Rr[i]) + (unsigned)Cc[i] * 2u;
            else voffA[h][i] = (unsigned)((h * HALF + Rr[i]) * S.lda + Cc[i]) * 2u;
            nvoffA[h][i] = voffA[h][i];
        }
    G_STAGE_B(G_SB(0, 0), cB); G_STAGE_A(G_SA(0, 0), cA, voffA, 0); G_STAGE_B(G_SB(0, 1), cB + hstepB); G_STAGE_A(G_SA(0, 1), cA, voffA, 1);
    if (wr == 1) G_BAR;
    G_WAIT_V(4); G_BAR;
    G_STAGE_B(G_SB(1, 0), cB + kstep); G_STAGE_A(G_SA(1, 0), cA + kstep, voffA, 0); G_STAGE_B(G_SB(1, 1), cB + hstepB + kstep);
    G_WAIT_V(6); G_BAR;
    for (;;) {
        const bool has_next = S.next(ui + 1, nxt);
        const char* nA = has_next ? S.a_base(nxt) : cA; const char* nB = has_next ? S.b_base(nxt) : cB;
        if constexpr (Sched::GATHER) {
            if (has_next) {
#pragma unroll
                for (int h = 0; h < 2; ++h)
#pragma unroll
                    for (int i = 0; i < 2; ++i) nvoffA[h][i] = S.a_row_off(nxt, h * HALF + Rr[i]) + (unsigned)Cc[i] * 2u;
            }
        }
#define G_ACC_FENCE \
        if constexpr (Epi::FP8) { \
            asm volatile("s_nop 15\n\ts_nop 15" : "+v"(acc[0][0][0][0]), "+v"(acc[0][0][0][1]), "+v"(acc[0][0][1][0]), "+v"(acc[0][0][1][1]), "+v"(acc[0][0][2][0]), "+v"(acc[0][0][2][1]), "+v"(acc[0][0][3][0]), "+v"(acc[0][0][3][1]), \
                                                 "+v"(acc[0][1][0][0]), "+v"(acc[0][1][0][1]), "+v"(acc[0][1][1][0]), "+v"(acc[0][1][1][1]), "+v"(acc[0][1][2][0]), "+v"(acc[0][1][2][1]), "+v"(acc[0][1][3][0]), "+v"(acc[0][1][3][1])); \
            asm volatile("" : "+v"(acc[1][0][0][0]), "+v"(acc[1][0][0][1]), "+v"(acc[1][0][1][0]), "+v"(acc[1][0][1][1]), "+v"(acc[1][0][2][0]), "+v"(acc[1][0][2][1]), "+v"(acc[1][0][3][0]), "+v"(acc[1][0][3][1]), \
                             "+v"(acc[1][1][0][0]), "+v"(acc[1][1][0][1]), "+v"(acc[1][1][1][0]), "+v"(acc[1][1][1][1]), "+v"(acc[1][1][2][0]), "+v"(acc[1][1][2][1]), "+v"(acc[1][1][3][0]), "+v"(acc[1][1][3][1])); \
        }
#define G_KLOOP(tb_, te_) \
        for (int t = tb_; t < te_; t += 2) { \
            const bool last = (t == nt - 2); \
            const char* a1 = cA + (size_t)(t + 1) * kstep; \
            const char* a2 = last ? nA : cA + (size_t)(t + 2) * kstep; const char* b2 = last ? nB : cB + (size_t)(t + 2) * kstep; \
            const char* a3 = a2 + kstep; const char* b3 = b2 + kstep; \
            unsigned vo2[2][2]; \
_Pragma("unroll") \
            for (int h = 0; h < 2; ++h) \
_Pragma("unroll") \
                for (int i = 0; i < 2; ++i) vo2[h][i] = (Sched::GATHER && last) ? nvoffA[h][i] : voffA[h][i]; \
            G_LDB(B0, 0, 0); G_SCHED; G_LDA(At, 0, 0); G_STAGE_A(G_SA(1, 1), a1, voffA, 1); \
            G_WAIT_L(8); G_BAR; G_WAIT_L(0); G_MMA(0, 0, At, B0); G_BAR; G_SCHED; \
            G_LDB(B1, 0, 1); G_STAGE_B(G_SB(0, 0), b2); \
            G_BAR; G_WAIT_L(0); G_MMA(0, 1, At, B1); G_BAR; \
            G_LDA(At, 0, 1); G_STAGE_A(G_SA(0, 0), a2, vo2, 0); \
            G_BAR; G_WAIT_L(0); G_MMA(1, 0, At, B0); G_BAR; G_SCHED; \
            G_STAGE_B(G_SB(0, 1), b2 + hstepB); \
            G_WAIT_V(6); G_BAR; G_MMA(1, 1, At, B1); G_BAR; \
            G_LDB(B0, 1, 0); G_SCHED; G_LDA(At, 1, 0); G_STAGE_A(G_SA(0, 1), a2, vo2, 1); \
            G_WAIT_L(8); G_BAR; G_WAIT_L(0); G_MMA(0, 0, At, B0); G_BAR; G_SCHED; \
            G_LDB(B1, 1, 1); G_STAGE_B(G_SB(1, 0), b3); \
            G_BAR; G_WAIT_L(0); G_MMA(0, 1, At, B1); G_BAR; \
            G_LDA(At, 1, 1); G_STAGE_A(G_SA(1, 0), a3, vo2, 0); \
            G_BAR; G_WAIT_L(0); G_MMA(1, 0, At, B0); G_BAR; G_SCHED; \
            G_STAGE_B(G_SB(1, 1), b3 + hstepB); \
            G_WAIT_V(6); G_BAR; G_MMA(1, 1, At, B1); G_BAR; \
        }
        if constexpr (Epi::MID_T >= 0) { G_KLOOP(0, Epi::MID_T) G_ACC_FENCE E.mid(acc, cur, wr, wc, fr, fq); G_KLOOP(Epi::MID_T, nt) }
        else { G_KLOOP(0, nt) }
#undef G_KLOOP
        G_ACC_FENCE
        E(acc, cur, wr, wc, fr, fq);
        if (!has_next) break;
#pragma unroll
        for (int a = 0; a < 2; ++a)
#pragma unroll
            for (int b = 0; b < 2; ++b)
#pragma unroll
                for (int m = 0; m < 4; ++m)
#pragma unroll
                    for (int n = 0; n < 2; ++n) acc[a][b][m][n] = (f32x4){0.f, 0.f, 0.f, 0.f};
        cur = nxt; cA = nA; cB = nB; ++ui;
        if constexpr (Sched::GATHER) {
#pragma unroll
            for (int h = 0; h < 2; ++h)
#pragma unroll
                for (int i = 0; i < 2; ++i) voffA[h][i] = nvoffA[h][i];
        }
    }
    G_WAIT_V(0);
    if (wr == 0) G_BAR;
    G_BAR;
#undef G_SA
#undef G_SB
#undef G_STAGE_A
#undef G_STAGE_B
#undef G_ACC_FENCE
#undef G_LD8
#undef G_LDA
#undef G_LDB
#undef G_MMA
#undef G_WAIT_V
#undef G_WAIT_L
#undef G_BAR
#undef G_SCHED
}

template <int NN>
struct DenseSchedT {
    static constexpr bool GATHER = false;
    const char* A; const char* Bt; int lda, ldb, G, c;
    __device__ __forceinline__ bool next(int i, Unit& u) const {
        constexpr int nwg = 128 * NN, q = nwg / 8, nig = 8 * NN;
        const int L = i * G + c; if (L >= nwg) return false;
        const int wgid = (L & 7) * q + (L >> 3);
        const int gid = wgid / nig, rem = wgid - gid * nig;
        u.pm = gid * 8 + (rem & 7); u.pn = rem >> 3; u.e = 0; return true;
    }
    __device__ __forceinline__ const char* a_base(const Unit& u) const { return A + (size_t)u.pm * 256 * lda * 2; }
    __device__ __forceinline__ unsigned a_row_off(const Unit&, int) const { return 0u; }
    __device__ __forceinline__ const char* b_base(const Unit& u) const { return Bt + (size_t)u.pn * 256 * ldb * 2; }
};
}
__device__ __forceinline__ int conv_row(int n, int mode) {
    if (mode == 0) return n;
    if (mode == 1) return n < 720 ? n : n + 48;
    return (n >> 7) * 256 + (n & 127) + (mode == 3 ? 128 : 0);
}
__device__ __forceinline__ void conv_job(ldsp_t lds, const float* src, int ld_src, int K, int N, bf16_t* dst, int ld_dst, int mode, int nbatch, size_t sb, size_t db) {
    LAS float* tile = (LAS float*)lds;
    const int tid = opaque_tid(), tk = K / 128, tn = (N + 127) / 128, per = tk * tn, total = per * nbatch;
    for (int t = blockIdx.x; t < total; t += gridDim.x) {
        const int bi = t / per, tt = t % per, k0 = (tt / tn) * 128, n0 = (tt % tn) * 128;
        const float* s = src + (size_t)bi * sb; bf16_t* d = dst + (size_t)bi * db;
        const int r = tid >> 5, c4 = (tid & 31) * 4;
        f32x4 v[8];
#pragma unroll
        for (int ps = 0; ps < 8; ++ps) { v[ps] = (f32x4){0.f, 0.f, 0.f, 0.f}; if (n0 + c4 < N) v[ps] = *(const f32x4*)(s + (size_t)(k0 + r + 16 * ps) * ld_src + n0 + c4); }
        __syncthreads();
#pragma unroll
        for (int ps = 0; ps < 8; ++ps) { const int k = r + 16 * ps; tile[k * 129 + c4 + 0] = v[ps][0]; tile[k * 129 + c4 + 1] = v[ps][1]; tile[k * 129 + c4 + 2] = v[ps][2]; tile[k * 129 + c4 + 3] = v[ps][3]; }
        __syncthreads();
        const int nn = tid >> 2, kq = tid & 3;
        if (n0 + nn < N) {
            bf16_t* drow = d + (size_t)conv_row(n0 + nn, mode) * ld_dst + k0;
#pragma unroll
            for (int ps = 0; ps < 4; ++ps) {
                const int k8 = (kq + 4 * ps) * 8;
                float f[8];
#pragma unroll
                for (int j = 0; j < 8; ++j) f[j] = tile[(k8 + j) * 129 + nn];
                u32x4 w; w.x = pk_bf16(f[0], f[1]); w.y = pk_bf16(f[2], f[3]); w.z = pk_bf16(f[4], f[5]); w.w = pk_bf16(f[6], f[7]);
                *(u32x4*)(drow + k8) = w;
            }
        }
    }
    __syncthreads();
}
__device__ __forceinline__ void conv_job8(ldsp_t lds, const float* src, int ld_src, int K, int N, unsigned char* dst, int ld_dst, int mode, int nbatch, size_t sb, size_t db, bool kperm = false) {
    const int tid = opaque_tid(), wv = __builtin_amdgcn_readfirstlane(tid >> 6), lane = tid & 63;
    const int tk = K / 128, tn = N / 128, per = tk * tn, total = per * nbatch, G = gridDim.x;
    const int hl = lane >> 5, slot = lane & 31;
    const int kb = tid & 15, nblk = tid >> 4;
    auto issue = [&](int t, int buf) {
        const int bi = t / per, tt = t % per, k0 = (tt / tn) * 128, n0 = (tt % tn) * 128;
        const float* s = src + (size_t)bi * sb + (size_t)k0 * ld_src + n0;
#pragma unroll
        for (int i = 0; i < 8; ++i) { const int row = (wv * 8 + i) * 2 + hl, piece = slot ^ ((row >> 3) & 15);
            __builtin_amdgcn_global_load_lds((const unsigned*)(s + (size_t)row * ld_src + piece * 4), (LAS unsigned*)(lds + buf * 65536 + (wv * 8 + i) * 1024), 16, 0, 0); }
    };
    int t = blockIdx.x, buf = 0;
    __syncthreads();
    if (t < total) issue(t, 0);
#pragma unroll 1
    for (; t < total; t += G, buf ^= 1) {
        if (t + G < total) { issue(t + G, buf ^ 1); asm volatile("s_waitcnt vmcnt(8)" ::: "memory"); } else asm volatile("s_waitcnt vmcnt(0)" ::: "memory");
        __syncthreads();
        const int bi = t / per, tt = t % per, k0 = (tt / tn) * 128, n0 = (tt % tn) * 128;
        f32x4 f[8];
#pragma unroll
        for (int j = 0; j < 8; ++j) f[j] = *(LAS const f32x4*)(lds + buf * 65536 + (kb * 8 + j) * 512 + ((nblk ^ kb) * 16));
        const int k8 = k0 + kb * 8;
        unsigned char* d = dst + (size_t)bi * db + (kperm ? (k8 & ~255) + ((k8 >> 5) & 3) * 64 + ((k8 >> 3) & 3) * 16 + ((k8 >> 7) & 1) * 8 : k8);
#pragma unroll
        for (int c = 0; c < 4; ++c) {
            const u32x2 w = pk8_fp8((f32x4){f[0][c], f[1][c], f[2][c], f[3][c]} * 64.0f, (f32x4){f[4][c], f[5][c], f[6][c], f[7][c]} * 64.0f);
            *(u32x2*)(d + (size_t)conv_row(n0 + nblk * 4 + c, mode) * ld_dst) = w;
        }
        __syncthreads();
    }
}
__device__ __forceinline__ void zero_fill16(unsigned char* dst, size_t bytes) {
    const size_t n = bytes / 16;
    for (size_t i = (size_t)blockIdx.x * NTHREADS + opaque_tid(); i < n; i += (size_t)gridDim.x * NTHREADS) ((u32x4*)dst)[i] = (u32x4){0u, 0u, 0u, 0u};
}

__device__ __forceinline__ void ph_conv_small(const Params& p, ldsp_t lds) {
    unsigned char* ws = p.ws;
    bf16_t* btin = (bf16_t*)(ws + O_BTIN); bf16_t* btq = (bf16_t*)(ws + O_BTQ); bf16_t* btab = (bf16_t*)(ws + O_BTAB);
    bf16_t* btbb = (bf16_t*)(ws + O_BTBB); bf16_t* bto = (bf16_t*)(ws + O_BTO); bf16_t* btr = (bf16_t*)(ws + O_BTR);
    const int tid = opaque_tid();
    conv_job(lds, p.w_in, IN_W, 2048, 720, btin, 2048, 0, 1, 0, 0);
    conv_job8(lds, p.w_in + 720, IN_W, 2048, 8192, ws + O_BTIN8, 2048, 0, 1, 0, 0);
    conv_job(lds, p.w_qidx, 1024, 512, 1024, btq + (size_t)2048 * 512, 512, 0, 1, 0, 0);
    conv_job8(lds, p.w_bb, 2048, 1024, 2048, (unsigned char*)btab + 2048, 3072, 0, 1, 0, 0);
    conv_job8(lds, p.w_o, 2048, 2048, 2048, (unsigned char*)bto, 2048, 0, 1, 0, 0, true);
    conv_job(lds, p.w_router, 64, 2048, 64, btr, 2048, 0, 1, 0, 0);
    zero_fill16((unsigned char*)(btin + (size_t)720 * 2048), (size_t)48 * 2048 * 2);
    zero_fill16((unsigned char*)(btr + (size_t)64 * 2048), (size_t)192 * 2048 * 2);
    if (blockIdx.x == 0) for (int i = tid; i < 1024; i += NTHREADS) { const float a = p.lbl[i], b = p.lbl[1024 + i]; ((float*)(ws + O_LB))[i] = 1.0f / (1.0f + __expf(b - a)); }
    for (int u = blockIdx.x; u < 256; u += gridDim.x) {
        const int n0 = u * 8, h = n0 >> 7, c0 = n0 & 127, r = tid;
        float sacc[8];
#pragma unroll
        for (int ci = 0; ci < 8; ++ci) sacc[ci] = 0.f;
#pragma unroll 2
        for (int d4 = 0; d4 < 32; ++d4) {
            const f32x4 v = *(const f32x4*)(p.w_uq + (size_t)r * 2048 + h * 128 + d4 * 4);
#pragma unroll
            for (int ci = 0; ci < 8; ++ci) { const f32x4 k4 = *(const f32x4*)(p.w_uk + ((size_t)h * 128 + c0 + ci) * 128 + d4 * 4);
                sacc[ci] += (v[0] * k4[0] + v[1] * k4[1]) + (v[2] * k4[2] + v[3] * k4[3]); }
        }
#pragma unroll
        for (int ci = 0; ci < 8; ++ci) btq[(size_t)(n0 + ci) * 512 + r] = f2bf(sacc[ci]);
    }
    for (int u = blockIdx.x; u < 256; u += gridDim.x) {
        const int h = u >> 4, nb = u & 15;
        LAS float* tb = (LAS float*)lds;
        __syncthreads();
        for (int i = tid; i < 64 * 32; i += NTHREADS) { const int v = i >> 5, n4 = (i & 31) * 4; const f32x4 x = *(const f32x4*)(p.w_ba + (size_t)(h * 64 + v) * 2048 + nb * 128 + n4);
            tb[v * 128 + n4] = x[0]; tb[v * 128 + n4 + 1] = x[1]; tb[v * 128 + n4 + 2] = x[2]; tb[v * 128 + n4 + 3] = x[3]; }
        __syncthreads();
        const int c = tid & 127, nq = tid >> 7;
        float aacc[32];
#pragma unroll
        for (int i = 0; i < 32; ++i) aacc[i] = 0.f;
#pragma unroll 1
        for (int v = 0; v < 64; ++v) {
            const float uvv = p.w_uv[((size_t)h * 128 + c) * 64 + v];
#pragma unroll
            for (int i4 = 0; i4 < 8; ++i4) { const f32x4 t4 = *(const LAS f32x4*)(tb + v * 128 + nq * 32 + i4 * 4);
                aacc[i4 * 4] += uvv * t4[0]; aacc[i4 * 4 + 1] += uvv * t4[1]; aacc[i4 * 4 + 2] += uvv * t4[2]; aacc[i4 * 4 + 3] += uvv * t4[3]; }
        }
        const int cp = ((c >> 2) & 3) * 32 + (c >> 4) * 4 + (c & 3);
#pragma unroll
        for (int i = 0; i < 32; ++i) ((unsigned char*)btab)[(size_t)(nb * 128 + nq * 32 + i) * 3072 + h * 128 + cp] = f2fp8(aacc[i] * 64.0f);
    }
    __syncthreads();
}

__device__ __forceinline__ void ph_conv_experts(const Params& p, ldsp_t lds) {
    unsigned char* btgu = p.ws + O_BTGU; unsigned char* btd = p.ws + O_BTD;
    conv_job8(lds, p.w_eg, 512, 2048, 512, btgu, 2048, 2, 64, (size_t)2048 * 512, (size_t)1024 * 2048);
    conv_job8(lds, p.w_eu, 512, 2048, 512, btgu, 2048, 3, 64, (size_t)2048 * 512, (size_t)1024 * 2048);
    conv_job8(lds, p.w_ed, 2048, 512, 2048, btd, 512, 0, 64, (size_t)512 * 2048, (size_t)2048 * 512);
    conv_job8(lds, p.w_sg, 512, 2048, 512, btgu + (size_t)64 * 1024 * 2048, 2048, 2, 1, 0, 0);
    conv_job8(lds, p.w_su, 512, 2048, 512, btgu + (size_t)64 * 1024 * 2048, 2048, 3, 1, 0, 0);
    conv_job8(lds, p.w_sd, 2048, 512, 2048, btd + (size_t)64 * 2048 * 512, 512, 0, 1, 0, 0);
}

__device__ __forceinline__ void ph_mod(const Params& p, ldsp_t lds) {
    LAS float* cond = (LAS float*)lds;
    LAS float* red = (LAS float*)(lds + 32768);
    float* mod = (float*)(p.ws + O_MOD);
    const int tid = opaque_tid();
    for (int w = blockIdx.x; w < 256; w += gridDim.x) {
        __syncthreads();
        for (int i = tid; i < 4 * 2048; i += NTHREADS) cond[i] = siluf_(p.c[i]);
        __syncthreads();
        if (tid < 384) {
            const int cq = tid % 12, kl = tid / 12;
            float a[4][4];
#pragma unroll
            for (int b = 0; b < 4; ++b)
#pragma unroll
                for (int j = 0; j < 4; ++j) a[b][j] = 0.f;
#pragma unroll 1
            for (int k0 = kl; k0 < 2048; k0 += 256) {
                f32x4 wv[8];
#pragma unroll
                for (int u8 = 0; u8 < 8; ++u8) wv[u8] = *(const f32x4*)(p.ada_w + (size_t)(k0 + 32 * u8) * 12288 + w * 48 + cq * 4);
#pragma unroll
                for (int u8 = 0; u8 < 8; ++u8) { const int k = k0 + 32 * u8;
#pragma unroll
                    for (int b = 0; b < 4; ++b) { const float cb = cond[b * 2048 + k];
#pragma unroll
                        for (int j = 0; j < 4; ++j) a[b][j] += cb * wv[u8][j]; } }
            }
#pragma unroll
            for (int b = 0; b < 4; ++b)
#pragma unroll
                for (int j = 0; j < 4; ++j) red[(kl * 12 + cq) * 16 + b * 4 + j] = a[b][j];
        }
        __syncthreads();
        if (tid < 192) {
            const int cq = tid / 16, bj = tid % 16, b = bj >> 2, j = bj & 3;
            float s = 0.f;
            for (int kl = 0; kl < 32; ++kl) s += red[(kl * 12 + cq) * 16 + bj];
            const int n = w * 48 + cq * 4 + j;
            mod[b * 12288 + n] = s + p.ada_b[n];
        }
    }
    __syncthreads();
}

__device__ __forceinline__ void ph_lnmod(const Params& p, ldsp_t lds) {
    const float* mod = (const float*)(p.ws + O_MOD);
    bf16_t* hn = (bf16_t*)(p.ws + O_HN); unsigned char* h8 = p.ws + O_H8;
    const int tid_ = opaque_tid(); const int lane = tid_ & 63, wv = tid_ >> 6;
    const bool bmap = gridDim.x == 256;
    const int row0 = bmap ? ((int)(blockIdx.x & 3) * SEQ + (int)(blockIdx.x >> 2) * 8 + wv) : (int)blockIdx.x * 8 + wv;
    const int rstride = bmap ? 512 : (int)gridDim.x * 8, rend = bmap ? ((int)(blockIdx.x & 3) + 1) * SEQ : NT;
    LAS float* psh = (LAS float*)lds;
    __syncthreads();
    if (bmap) { const int b = blockIdx.x & 3; for (int i = tid_; i < 2048; i += NTHREADS) { psh[i] = mod[b * 12288 + i]; psh[2048 + i] = mod[b * 12288 + 2048 + i] + 1.0f; } }
    else { for (int i = tid_; i < 4 * 2048; i += NTHREADS) { const int b = i >> 11, c = i & 2047; psh[b * 4096 + c] = mod[b * 12288 + c]; psh[b * 4096 + 2048 + c] = mod[b * 12288 + 2048 + c] + 1.0f; } }
    __syncthreads();
#pragma unroll 1
    for (int row = row0; row < rend; row += rstride) {
        const LAS float* sh = bmap ? psh : psh + (row >> 13) * 4096;
        const float* xr = p.x + (size_t)row * 2048;
        f32x4 v[8]; float s = 0.f;
#pragma unroll
        for (int i = 0; i < 8; ++i) { v[i] = *(const f32x4*)(xr + (i * 64 + lane) * 4); s += (v[i][0] + v[i][1]) + (v[i][2] + v[i][3]); }
        const float mu = wave_sum(s) * (1.0f / 2048.0f);
        float q = 0.f;
#pragma unroll
        for (int i = 0; i < 8; ++i) { v[i] -= mu; q += (v[i][0] * v[i][0] + v[i][1] * v[i][1]) + (v[i][2] * v[i][2] + v[i][3] * v[i][3]); }
        const float rstd = rsqrtf(wave_sum(q) * (1.0f / 2048.0f) + LN_EPS);
#pragma unroll
        for (int i = 0; i < 8; ++i) {
            const int col = (i * 64 + lane) * 4;
            const f32x4 y = v[i] * rstd * *(const LAS f32x4*)(sh + 2048 + col) + *(const LAS f32x4*)(sh + col);
            u32x2 w; w.x = pk_bf16(y[0], y[1]); w.y = pk_bf16(y[2], y[3]);
            *(u32x2*)(hn + (size_t)row * 2048 + col) = w;
            { int q8 = 0; q8 = __builtin_amdgcn_cvt_pk_fp8_f32(y[0], y[1], q8, false); q8 = __builtin_amdgcn_cvt_pk_fp8_f32(y[2], y[3], q8, true); *(int*)(h8 + (size_t)row * 2048 + col) = q8; }
        }
    }
    __syncthreads();
}
using gm::Unit;
__device__ __forceinline__ unsigned pk_f16(float lo, float hi) { const _Float16 a = (_Float16)lo, b = (_Float16)hi; return (unsigned)__builtin_bit_cast(unsigned short, a) | ((unsigned)__builtin_bit_cast(unsigned short, b) << 16); }
__device__ __forceinline__ void st8_bf16(bf16_t* dst, const f32x4& v0, const f32x4& v1) {
    u32x4 w; w.x = pk_bf16(v0[0], v0[1]); w.y = pk_bf16(v0[2], v0[3]); w.z = pk_bf16(v1[0], v1[1]); w.w = pk_bf16(v1[2], v1[3]); *(u32x4*)dst = w; }

template <bool F8>
struct EpiInProj {
    static constexpr bool PERM = true; static constexpr int MID_T = -1; static constexpr bool FP8 = F8;
    unsigned char* ws;
    __device__ __forceinline__ void operator()(const f32x4 (&acc)[2][2][4][2], const Unit& u, int wr, int wc, int fr, int fq) const {
        const int pn = u.pn + (F8 ? 3 : 0); const int row0 = u.pm * 256 + wr * 64 + fr;
        const float* lb = (const float*)(ws + O_LB);
        int type, cbase, ldo; bf16_t* base;
        if (pn < 3) { type = 0; base = (bf16_t*)(ws + O_PSM); cbase = pn * 256; ldo = 768; }
        else if (pn < 7) { type = 1; base = (bf16_t*)(ws + O_QB); cbase = (pn - 3) * 256; ldo = 1024; }
        else if (pn < 11) { type = 2; base = (bf16_t*)(ws + O_LF); cbase = (pn - 7) * 256; ldo = 1024; }
        else if (pn < 15) { type = 0; base = (bf16_t*)(ws + O_V); cbase = (pn - 11) * 256; ldo = 1024; }
        else if (pn < 19) { type = 3; base = (bf16_t*)(ws + O_G); cbase = (pn - 15) * 256; ldo = 1024; }
        else if (pn < 27) { type = 4; base = (bf16_t*)(ws + O_SGA); cbase = (pn - 19) * 256; ldo = 2048; }
        else { type = 4; base = (bf16_t*)(ws + O_SGB); cbase = (pn - 27) * 256; ldo = 2048; }
        if (type == 4) {
#pragma unroll
            for (int ai = 0; ai < 2; ++ai)
#pragma unroll
                for (int m = 0; m < 4; ++m) {
                    const int row = row0 + ai * 128 + m * 16;
                    unsigned w[4] = {0u, 0u, 0u, 0u};
#pragma unroll
                    for (int bj = 0; bj < 2; ++bj)
#pragma unroll
                        for (int j = 0; j < 4; ++j) { w[2 * bj] |= (unsigned)(sigmoidf_(acc[ai][bj][m][0][j] * (1.0f / 64.0f)) * 255.0f + 0.5f) << (8 * j); w[2 * bj + 1] |= (unsigned)(sigmoidf_(acc[ai][bj][m][1][j] * (1.0f / 64.0f)) * 255.0f + 0.5f) << (8 * j); }
                    *(u32x4*)((unsigned char*)base + (size_t)row * 2048 + cbase + wc * 64 + fq * 16) = (u32x4){w[0], w[1], w[2], w[3]};
                }
            return;
        }
#pragma unroll
        for (int bj = 0; bj < 2; ++bj) {
            const int col = cbase + bj * 128 + wc * 32 + 8 * fq;
            f32x4 l0 = (f32x4){0.f, 0.f, 0.f, 0.f}, l1 = l0;
            if (type == 2) { l0 = *(const f32x4*)(lb + col); l1 = *(const f32x4*)(lb + col + 4); }
#pragma unroll
            for (int ai = 0; ai < 2; ++ai)
#pragma unroll
                for (int m = 0; m < 4; ++m) {
                    const int row = row0 + ai * 128 + m * 16;
                    f32x4 v0 = acc[ai][bj][m][0], v1 = acc[ai][bj][m][1];
                    if (F8) { v0 *= (1.0f / 64.0f); v1 *= (1.0f / 64.0f); }
                    bf16_t* dst = base + (size_t)row * ldo + col;
                    if (type == 2) {
                        float f[8];
#pragma unroll
                        for (int j = 0; j < 4; ++j) { f[j] = __logf(l0[j] + (1.0f - l0[j]) * sigmoidf_(v0[j])); f[4 + j] = __logf(l1[j] + (1.0f - l1[j]) * sigmoidf_(v1[j])); }
                        u32x4 w; w.x = pk_f16(f[0], f[1]); w.y = pk_f16(f[2], f[3]); w.z = pk_f16(f[4], f[5]); w.w = pk_f16(f[6], f[7]);
                        *(u32x4*)dst = w;
                    } else {
                        if (type == 1) {
#pragma unroll
                            for (int j = 0; j < 4; ++j) { v0[j] = siluf_(v0[j]) * 0.08838834764831845f; v1[j] = siluf_(v1[j]) * 0.08838834764831845f; }
                        } else if (type == 3) {
#pragma unroll
                            for (int j = 0; j < 4; ++j) { v0[j] = siluf_(v0[j]); v1[j] = siluf_(v1[j]); }
                        }
                        st8_bf16(dst, v0, v1);
                    }
                }
        }
    }
};
struct EpiQ {
    static constexpr bool PERM = true; static constexpr int MID_T = -1; static constexpr bool FP8 = false;
    unsigned char* ws;
    __device__ __forceinline__ void operator()(const f32x4 (&acc)[2][2][4][2], const Unit& u, int wr, int wc, int fr, int fq) const {
        const int pn = u.pn; const int row0 = u.pm * 256 + wr * 64 + fr;
        const bool lat = pn < 8;
        bf16_t* base = (bf16_t*)(ws + (lat ? O_QLAT : O_QIDX)); const int ldo = lat ? 2048 : 1024, cbase = (lat ? pn : pn - 8) * 256; const float sc = lat ? 0.08838834764831845f : 1.0f;
#pragma unroll
        for (int ai = 0; ai < 2; ++ai)
#pragma unroll
            for (int m = 0; m < 4; ++m)
#pragma unroll
                for (int bj = 0; bj < 2; ++bj) {
                    const int row = row0 + ai * 128 + m * 16, col = cbase + bj * 128 + wc * 32 + 8 * fq;
                    st8_bf16(base + (size_t)row * ldo + col, acc[ai][bj][m][0] * sc, acc[ai][bj][m][1] * sc);
                }
    }
};
__device__ __forceinline__ void unpack8(const u32x4& g, float (&f)[8]) {
    f[0] = __uint_as_float(g.x << 16); f[1] = __uint_as_float(g.x & 0xffff0000u); f[2] = __uint_as_float(g.y << 16); f[3] = __uint_as_float(g.y & 0xffff0000u);
    f[4] = __uint_as_float(g.z << 16); f[5] = __uint_as_float(g.z & 0xffff0000u); f[6] = __uint_as_float(g.w << 16); f[7] = __uint_as_float(g.w & 0xffff0000u); }
__device__ __forceinline__ void unpack8u(const u32x2& g, float (&f)[8]) {
    f[0] = (float)((g.x >> 0) & 0xffu); f[1] = (float)((g.x >> 8) & 0xffu); f[2] = (float)((g.x >> 16) & 0xffu); f[3] = (float)((g.x >> 24) & 0xffu);
    f[4] = (float)((g.y >> 0) & 0xffu); f[5] = (float)((g.y >> 8) & 0xffu); f[6] = (float)((g.y >> 16) & 0xffu); f[7] = (float)((g.y >> 24) & 0xffu); }
struct EpiMergeA {
    static constexpr bool PERM = true; static constexpr int MID_T = -1; static constexpr bool FP8 = true;
    unsigned char* ws; bf16_t* m1;
    __device__ __forceinline__ void operator()(const f32x4 (&acc)[2][2][4][2], const Unit& u, int wr, int wc, int fr, int fq) const {
        const int row0 = u.pm * 256 + wr * 64 + fr; const unsigned char* __restrict__ sg = ws + O_SGA;
        const int colb = u.pn * 256 + wc * 32 + 8 * fq;
#pragma unroll
        for (int ai = 0; ai < 2; ++ai) {
            u32x2 g[4][2];
#pragma unroll
            for (int m = 0; m < 4; ++m) { const u32x4 gq = *(const u32x4*)(sg + (size_t)(row0 + ai * 128 + m * 16) * 2048 + u.pn * 256 + wc * 64 + fq * 16);
                g[m][0] = (u32x2){gq.x, gq.y}; g[m][1] = (u32x2){gq.z, gq.w}; }
#pragma unroll
            for (int m = 0; m < 4; ++m)
#pragma unroll
                for (int bj = 0; bj < 2; ++bj) {
                    float f[8]; unpack8u(g[m][bj], f);
                    f32x4 o0, o1;
#pragma unroll
                    for (int j = 0; j < 4; ++j) { o0[j] = f[j] * acc[ai][bj][m][0][j] * (1.0f / (255.0f * 64.0f * OSCALE)); o1[j] = f[4 + j] * acc[ai][bj][m][1][j] * (1.0f / (255.0f * 64.0f * OSCALE)); }
                    st8_bf16(m1 + (size_t)(row0 + ai * 128 + m * 16) * 2048 + colb + bj * 128, o0, o1);
                }
        }
    }
};
struct EpiMergeB {
    static constexpr bool PERM = true; static constexpr int MID_T = -1; static constexpr bool FP8 = true;
    unsigned char* ws; const bf16_t* m1;
    __device__ __forceinline__ void operator()(const f32x4 (&acc)[2][2][4][2], const Unit& u, int wr, int wc, int fr, int fq) const {
        const int row0 = u.pm * 256 + wr * 64 + fr; const unsigned char* __restrict__ sg = ws + O_SGB; unsigned char* mix = ws + O_MIX;
        const int colb = u.pn * 256 + wc * 32 + 8 * fq, pos = u.pn * 256 + wc * 64 + fq * 16;
#pragma unroll
        for (int ai = 0; ai < 2; ++ai)
#pragma unroll
            for (int mh = 0; mh < 2; ++mh) {
                u32x4 g[2], a[2][2];
#pragma unroll
                for (int mm = 0; mm < 2; ++mm) { const size_t ro = (size_t)(row0 + ai * 128 + (2 * mh + mm) * 16) * 2048; g[mm] = *(const u32x4*)(sg + ro + pos);
                    a[mm][0] = *(const u32x4*)(m1 + ro + colb); a[mm][1] = *(const u32x4*)(m1 + ro + colb + 128); }
#pragma unroll
                for (int mm = 0; mm < 2; ++mm) { const int m = 2 * mh + mm;
                    u32x2 w8[2];
#pragma unroll
                    for (int bj = 0; bj < 2; ++bj) {
                        float f[8], pa[8]; unpack8u(bj ? (u32x2){g[mm].z, g[mm].w} : (u32x2){g[mm].x, g[mm].y}, f); unpack8(a[mm][bj], pa);
                        f32x4 o0, o1;
#pragma unroll
                        for (int j = 0; j < 4; ++j) { o0[j] = (pa[j] + f[j] * acc[ai][bj][m][0][j] * (1.0f / (255.0f * 64.0f * OSCALE))) * MSCALE; o1[j] = (pa[4 + j] + f[4 + j] * acc[ai][bj][m][1][j] * (1.0f / (255.0f * 64.0f * OSCALE))) * MSCALE; }
                        w8[bj] = pk8_fp8(o0, o1);
                    }
                    *(u32x4*)(mix + (size_t)(row0 + ai * 128 + m * 16) * 2048 + pos) = (u32x4){w8[0].x, w8[0].y, w8[1].x, w8[1].y};
                }
            }
    }
};
struct EpiWo {
    static constexpr bool PERM = true; static constexpr int MID_T = -1; static constexpr bool FP8 = true;
    const float* x; const float* mod; bf16_t* r;
    __device__ __forceinline__ void operator()(const f32x4 (&acc)[2][2][4][2], const Unit& u, int wr, int wc, int fr, int fq) const {
        const int row0 = u.pm * 256 + wr * 64 + fr; const int b = (u.pm * 256) >> 13;
        const float* __restrict__ xx = x;
#pragma unroll
        for (int bj = 0; bj < 2; ++bj) {
            const int col = u.pn * 256 + bj * 128 + wc * 32 + 8 * fq;
            const f32x4 g0 = *(const f32x4*)(mod + b * 12288 + 2 * 2048 + col), g1 = *(const f32x4*)(mod + b * 12288 + 2 * 2048 + col + 4);
#pragma unroll
            for (int ai = 0; ai < 2; ++ai) {
                f32x4 x0[4], x1[4];
#pragma unroll
                for (int m = 0; m < 4; ++m) { const float* xr = xx + (size_t)(row0 + ai * 128 + m * 16) * 2048 + col; x0[m] = *(const f32x4*)xr; x1[m] = *(const f32x4*)(xr + 4); }
#pragma unroll
                for (int m = 0; m < 4; ++m) st8_bf16(r + (size_t)(row0 + ai * 128 + m * 16) * 2048 + col, x0[m] * DN_ALPHA + g0 * (acc[ai][bj][m][0] * (1.0f / (64.0f * MSCALE))), x1[m] * DN_ALPHA + g1 * (acc[ai][bj][m][1] * (1.0f / (64.0f * MSCALE))));
            }
        }
    }
};
struct EpiRouter {
    static constexpr bool PERM = false; static constexpr int MID_T = -1; static constexpr bool FP8 = false;
    float* logit;
    __device__ __forceinline__ void operator()(const f32x4 (&acc)[2][2][4][2], const Unit& u, int wr, int wc, int fr, int fq) const {
        const int row0 = u.pm * 256 + wr * 64 + fr;
        if (wc < 2) {
#pragma unroll
            for (int n = 0; n < 2; ++n)
#pragma unroll
                for (int ai = 0; ai < 2; ++ai)
#pragma unroll
                    for (int m = 0; m < 4; ++m) {
                        const int row = row0 + ai * 128 + m * 16, col = wc * 32 + n * 16 + 4 * fq;
                        *(f32x4*)(logit + (size_t)row * 64 + col) = acc[ai][0][m][n];
                    }
        }
    }
};
constexpr float WSCALE = 64.0f, HSCALE = 4.0f;
struct EpiExp1 {
    static constexpr bool PERM = true; static constexpr int MID_T = -1; static constexpr bool FP8 = true;
    unsigned char* hh;
    __device__ __forceinline__ void operator()(const f32x4 (&acc)[2][2][4][2], const Unit& u, int wr, int wc, int fr, int fq) const {
        const int row0 = u.pm * 256 + wr * 64 + fr;
#pragma unroll
        for (int ai = 0; ai < 2; ++ai)
#pragma unroll
            for (int m = 0; m < 4; ++m) {
                const int row = row0 + ai * 128 + m * 16, col = u.pn * 128 + wc * 32 + 8 * fq;
                f32x4 o0, o1;
#pragma unroll
                for (int j = 0; j < 4; ++j) { o0[j] = siluf_(acc[ai][0][m][0][j] * (1.0f / WSCALE)) * acc[ai][1][m][0][j] * (HSCALE / WSCALE);
                                              o1[j] = siluf_(acc[ai][0][m][1][j] * (1.0f / WSCALE)) * acc[ai][1][m][1][j] * (HSCALE / WSCALE); }
                *(u32x2*)(hh + (size_t)row * 512 + col) = pk8_fp8(o0, o1);
            }
    }
};
struct EpiExp2 {
    static constexpr bool PERM = true; static constexpr int MID_T = -1; static constexpr bool FP8 = true;
    unsigned char* y; const u32x2* wd; const bf16_t* t16; bf16_t* t16o; const float* mod;
    __device__ __forceinline__ void operator()(const f32x4 (&acc)[2][2][4][2], const Unit& u, int wr, int wc, int fr, int fq) const {
        const int row0 = u.pm * 256 + wr * 64 + fr;
        int dsts[2][4]; float wts[2][4];
#pragma unroll
        for (int ai = 0; ai < 2; ++ai)
#pragma unroll
            for (int m = 0; m < 4; ++m) { const u32x2 q = wd[row0 + ai * 128 + m * 16]; dsts[ai][m] = (int)q.y; wts[ai][m] = __uint_as_float(q.x) * (YSCALE / (WSCALE * HSCALE)); }
        if (u.e < 64) {
#pragma unroll
            for (int ai = 0; ai < 2; ++ai)
#pragma unroll
                for (int m = 0; m < 4; ++m) {
                    const int dst = dsts[ai][m]; const float w = wts[ai][m];
                    if (dst >= 0) {
                        const u32x2 lo = pk8_fp8(acc[ai][0][m][0] * w, acc[ai][0][m][1] * w), hi = pk8_fp8(acc[ai][1][m][0] * w, acc[ai][1][m][1] * w);
                        *(u32x4*)(y + (size_t)dst * 2048 + u.pn * 256 + wc * 64 + fq * 16) = (u32x4){lo.x, lo.y, hi.x, hi.y};
                    }
                }
        } else {
#pragma unroll
            for (int ai = 0; ai < 2; ++ai)
#pragma unroll
                for (int bj = 0; bj < 2; ++bj) {
                    const int col = u.pn * 256 + bj * 128 + wc * 32 + 8 * fq;
                    const float* gr = mod + (dsts[0][0] >> 13) * 12288 + 5 * 2048 + col;
                    const f32x4 g0 = *(const f32x4*)gr, g1 = *(const f32x4*)(gr + 4);
                    u32x4 xx[4];
#pragma unroll
                    for (int m = 0; m < 4; ++m) xx[m] = *(const u32x4*)(t16 + (size_t)dsts[ai][m] * 2048 + col);
#pragma unroll
                    for (int m = 0; m < 4; ++m) { float f[8]; unpack8(xx[m], f);
                        f32x4 o0, o1;
#pragma unroll
                        for (int j = 0; j < 4; ++j) { o0[j] = f[j] * DN_ALPHA + g0[j] * (acc[ai][bj][m][0][j] * (1.0f / (WSCALE * HSCALE))); o1[j] = f[4 + j] * DN_ALPHA + g1[j] * (acc[ai][bj][m][1][j] * (1.0f / (WSCALE * HSCALE))); }
                        st8_bf16(t16o + (size_t)dsts[ai][m] * 2048 + col, o0, o1); }
                }
        }
    }
};
struct Exp1Sched {
    static constexpr bool GATHER = true;
    const char* h2; const char* btgu; const int* tokof; const int* tilee; int ntiles, G, c; int lda, ldb;
    __device__ __forceinline__ bool next(int i, Unit& u) const {
        if (G == 256) { const int v = c & 7, r = c >> 3, grp = i * 8 + v, tile = grp * 8 + (r & 7); if (tile >= ntiles) return false; u.pm = tile; u.pn = r >> 3; }
        else { const int L = i * G + c; if (L >= ntiles * 4) return false; u.pm = L >> 2; u.pn = L & 3; }
        u.e = __builtin_amdgcn_readfirstlane(tilee[u.pm]); return true; }
    __device__ __forceinline__ const char* a_base(const Unit&) const { return h2; }
    __device__ __forceinline__ unsigned a_row_off(const Unit& u, int r) const { return (unsigned)tokof[u.pm * 256 + r] * 2048u; }
    __device__ __forceinline__ const char* b_base(const Unit& u) const { return btgu + ((size_t)u.e * 1024 + u.pn * 256) * 2048; }
};
struct Exp2Sched {
    static constexpr bool GATHER = false;
    const char* hh; const char* btd; const int* tilee; int ntiles, G, c; int lda, ldb;
    __device__ __forceinline__ bool next(int i, Unit& u) const {
        if (G == 256) { const int v = c & 7, r = c >> 3, grp = i * 8 + v, tile = grp * 4 + (r & 3); if (tile >= ntiles) return false; u.pm = tile; u.pn = r >> 2; }
        else { const int L = i * G + c; if (L >= ntiles * 8) return false; u.pm = L >> 3; u.pn = L & 7; }
        u.e = __builtin_amdgcn_readfirstlane(tilee[u.pm]); return true; }
    __device__ __forceinline__ const char* a_base(const Unit& u) const { return hh + (size_t)u.pm * 256 * 512; }
    __device__ __forceinline__ unsigned a_row_off(const Unit&, int) const { return 0u; }
    __device__ __forceinline__ const char* b_base(const Unit& u) const { return btd + ((size_t)u.e * 2048 + u.pn * 256) * 512; }
};
template <int NN> __device__ __forceinline__ gm::DenseSchedT<NN> dense(const void* A, int lda, const void* Bt, int ldb) {
    gm::DenseSchedT<NN> s; s.A = (const char*)A; s.Bt = (const char*)Bt; s.lda = lda; s.ldb = ldb; s.G = gridDim.x; s.c = blockIdx.x; return s; }
__device__ __forceinline__ void ph_smallnorm(const Params& p) {
    const bf16_t* psm = (const bf16_t*)(p.ws + O_PSM);
    bf16_t* cqn = (bf16_t*)(p.ws + O_CQN); bf16_t* kv = (bf16_t*)(p.ws + O_KV); bf16_t* kidx = (bf16_t*)(p.ws + O_KIDX); float* widx = (float*)(p.ws + O_WIDX);
    const int tid_ = opaque_tid(); const int lane = tid_ & 63, wv = tid_ >> 6;
    const f32x4 qg0 = *(const f32x4*)(p.qng + lane * 8), qg1 = *(const f32x4*)(p.qng + lane * 8 + 4);
    const int pc_ = lane < 16 ? lane * 8 : (lane < 24 ? (lane - 16) * 8 : 0);
    const float* gsrc = lane < 16 ? p.kvng : p.ikg;
    const f32x4 sg0 = *(const f32x4*)(gsrc + pc_), sg1 = *(const f32x4*)(gsrc + pc_ + 4), sb0 = *(const f32x4*)(p.ikb + (lane < 16 ? 0 : pc_)), sb1 = *(const f32x4*)(p.ikb + (lane < 16 ? 0 : pc_) + 4);
    const int srow0 = blockIdx.x * 8 + wv, sstride = gridDim.x * 8;
    u32x4 an = (u32x4){0u, 0u, 0u, 0u}, bn = an;
    if (srow0 < NT) { an = *(const u32x4*)(psm + (size_t)srow0 * 768 + lane * 8); if (lane < 26) bn = *(const u32x4*)(psm + (size_t)srow0 * 768 + 512 + lane * 8); }
#pragma unroll 1
    for (int row = srow0; row < NT; row += sstride) {
        const u32x4 a = an, bcur = bn;
        { const int rn = (row + sstride < NT) ? row + sstride : row; an = *(const u32x4*)(psm + (size_t)rn * 768 + lane * 8); if (lane < 26) bn = *(const u32x4*)(psm + (size_t)rn * 768 + 512 + lane * 8); }
        float f[8];
        f[0] = __uint_as_float(a.x << 16); f[1] = __uint_as_float(a.x & 0xffff0000u); f[2] = __uint_as_float(a.y << 16); f[3] = __uint_as_float(a.y & 0xffff0000u);
        f[4] = __uint_as_float(a.z << 16); f[5] = __uint_as_float(a.z & 0xffff0000u); f[6] = __uint_as_float(a.w << 16); f[7] = __uint_as_float(a.w & 0xffff0000u);
        float ss = 0.f;
#pragma unroll
        for (int j = 0; j < 8; ++j) ss += f[j] * f[j];
        const float r1 = rsqrtf(wave_sum(ss) * (1.0f / 512.0f) + LN_EPS);
        {
            const f32x4 g0 = qg0, g1 = qg1;
            u32x4 w; w.x = pk_bf16(f[0] * r1 * g0[0], f[1] * r1 * g0[1]); w.y = pk_bf16(f[2] * r1 * g0[2], f[3] * r1 * g0[3]);
            w.z = pk_bf16(f[4] * r1 * g1[0], f[5] * r1 * g1[1]); w.w = pk_bf16(f[6] * r1 * g1[2], f[7] * r1 * g1[3]);
            *(u32x4*)(cqn + (size_t)row * 512 + lane * 8) = w;
        }
        float g[8];
        {
            const u32x4 b = (lane < 26) ? bcur : (u32x4){0u, 0u, 0u, 0u};
            g[0] = __uint_as_float(b.x << 16); g[1] = __uint_as_float(b.x & 0xffff0000u); g[2] = __uint_as_float(b.y << 16); g[3] = __uint_as_float(b.y & 0xffff0000u);
            g[4] = __uint_as_float(b.z << 16); g[5] = __uint_as_float(b.z & 0xffff0000u); g[6] = __uint_as_float(b.w << 16); g[7] = __uint_as_float(b.w & 0xffff0000u);
        }
        float s1 = 0.f, s2 = 0.f;
#pragma unroll
        for (int j = 0; j < 8; ++j) { s1 += g[j]; s2 += g[j] * g[j]; }
        const float kvss = wave_sum(lane < 16 ? s2 : 0.f);
        const float kis = wave_sum((lane >= 16 && lane < 24) ? s1 : 0.f);
        const float mu = kis * (1.0f / 64.0f);
        float dq = 0.f;
#pragma unroll
        for (int j = 0; j < 8; ++j) dq += (g[j] - mu) * (g[j] - mu);
        const float kiv = wave_sum((lane >= 16 && lane < 24) ? dq : 0.f) * (1.0f / 64.0f);
        if (lane < 16) {
            const float r2 = rsqrtf(kvss * (1.0f / 128.0f) + LN_EPS);
            const f32x4 g0 = sg0, g1 = sg1;
            u32x4 w; w.x = pk_bf16(g[0] * r2 * g0[0], g[1] * r2 * g0[1]); w.y = pk_bf16(g[2] * r2 * g0[2], g[3] * r2 * g0[3]);
            w.z = pk_bf16(g[4] * r2 * g1[0], g[5] * r2 * g1[1]); w.w = pk_bf16(g[6] * r2 * g1[2], g[7] * r2 * g1[3]);
            *(u32x4*)(kv + (size_t)row * 128 + lane * 8) = w;
        } else if (lane < 24) {
            const int c = (lane - 16) * 8; const float r3 = rsqrtf(kiv + LN_EPS);
            const f32x4 g0 = sg0, g1 = sg1, b0 = sb0, b1 = sb1;
            u32x4 w; w.x = pk_bf16((g[0] - mu) * r3 * g0[0] + b0[0], (g[1] - mu) * r3 * g0[1] + b0[1]); w.y = pk_bf16((g[2] - mu) * r3 * g0[2] + b0[2], (g[3] - mu) * r3 * g0[3] + b0[3]);
            w.z = pk_bf16((g[4] - mu) * r3 * g1[0] + b1[0], (g[5] - mu) * r3 * g1[1] + b1[1]); w.w = pk_bf16((g[6] - mu) * r3 * g1[2] + b1[2], (g[7] - mu) * r3 * g1[3] + b1[3]);
            *(u32x4*)(kidx + (size_t)row * 64 + c) = w;
        } else if (lane < 26) {
            const int c = (lane - 24) * 8;
            *(f32x4*)(widx + (size_t)row * 16 + c) = (f32x4){g[0], g[1], g[2], g[3]} * 0.03125f;
            *(f32x4*)(widx + (size_t)row * 16 + c + 4) = (f32x4){g[4], g[5], g[6], g[7]} * 0.03125f;
        }
    }
}

__device__ __forceinline__ unsigned short score_key(float s) {
    const unsigned short h = __builtin_bit_cast(unsigned short, (_Float16)s);
    const unsigned short m = (unsigned short)((short)h >> 15);
    return (unsigned short)(h ^ (m | 0x8000u));
}
__device__ __forceinline__ int wave_sum_fast(int v) {
    v += __builtin_amdgcn_update_dpp(0, v, 0xB1, 0xf, 0xf, false);
    v += __builtin_amdgcn_update_dpp(0, v, 0x4E, 0xf, 0xf, false);
    v += __builtin_amdgcn_update_dpp(0, v, 0x141, 0xf, 0xf, false);
    v += __builtin_amdgcn_update_dpp(0, v, 0x140, 0xf, 0xf, false);
    u32x2 r = __builtin_amdgcn_permlane16_swap(v, v, false, false); v = r[0] + r[1];
    r = __builtin_amdgcn_permlane32_swap(v, v, false, false); v = r[0] + r[1];
    return v;
}
__device__ __forceinline__ unsigned cnt_ge4(unsigned cnt, const u32x4& v, unsigned tm1pk) {
    unsigned t0, t1, t2, t3;
    asm("v_pk_sub_u16 %0, %1, %2 clamp" : "=v"(t0) : "v"(v.x), "v"(tm1pk));
    asm("v_pk_sub_u16 %0, %1, %2 clamp" : "=v"(t1) : "v"(v.y), "v"(tm1pk));
    asm("v_pk_sub_u16 %0, %1, %2 clamp" : "=v"(t2) : "v"(v.z), "v"(tm1pk));
    asm("v_pk_sub_u16 %0, %1, %2 clamp" : "=v"(t3) : "v"(v.w), "v"(tm1pk));
    const unsigned one = 0x00010001u;
    asm("v_pk_min_u16 %0, %1, %2" : "=v"(t0) : "v"(t0), "v"(one));
    asm("v_pk_min_u16 %0, %1, %2" : "=v"(t1) : "v"(t1), "v"(one));
    asm("v_pk_min_u16 %0, %1, %2" : "=v"(t2) : "v"(t2), "v"(one));
    asm("v_pk_min_u16 %0, %1, %2" : "=v"(t3) : "v"(t3), "v"(one));
    asm("v_pk_add_u16 %0, %1, %2" : "=v"(t0) : "v"(t0), "v"(t1));
    asm("v_pk_add_u16 %0, %1, %2" : "=v"(t2) : "v"(t2), "v"(t3));
    asm("v_pk_add_u16 %0, %1, %2" : "=v"(t0) : "v"(t0), "v"(t2));
    asm("v_pk_add_u16 %0, %1, %2" : "=v"(cnt) : "v"(cnt), "v"(t0));
    return cnt;
}
typedef _Float16 h2_t __attribute__((ext_vector_type(2)));
typedef short s2_t __attribute__((ext_vector_type(2)));
__device__ __forceinline__ float relu_(float x) { return __builtin_amdgcn_fmed3f(x, 0.0f, __builtin_inff()); }
__device__ __forceinline__ void ph_indexer(const Params& p, ldsp_t lds, const int nsel_rep) {
    const bf16_t* qidx = (const bf16_t*)(p.ws + O_QIDX); const bf16_t* kidx = (const bf16_t*)(p.ws + O_KIDX); const float* widx = (const float*)(p.ws + O_WIDX);
    u16* sel = (u16*)(p.ws + O_SEL);
    LAS u16* sc = (LAS u16*)lds;
    ldsp_t kt = lds + 32768;
    unsigned bwo = LDS_BYTES - 16; asm volatile("" : "+v"(bwo));
    const LAS unsigned* bwp = (const LAS unsigned*)(lds + bwo);
    const unsigned bw0 = __builtin_amdgcn_readfirstlane(bwp[0]), bw1 = __builtin_amdgcn_readfirstlane(bwp[1]), bw2 = __builtin_amdgcn_readfirstlane(bwp[2]), bw3 = __builtin_amdgcn_readfirstlane(bwp[3]);
    __syncthreads();
    const int tid = opaque_tid(), lane = tid & 63, wv = __builtin_amdgcn_readfirstlane(tid >> 6), rb = wv & 3, kb = wv >> 2;
    const int l31 = lane & 31, hh = lane >> 5;
    const int drow = 8 * wv + (lane >> 3), dchunk = (lane & 7) ^ ((drow >> 1) & 7);
    const int krow = kb * 32 + l31;
    unsigned boff[4];
#pragma unroll
    for (int kk = 0; kk < 4; ++kk) boff[kk] = (unsigned)(krow * 128 + (((2 * kk + hh) ^ ((krow >> 1) & 7)) * 16));
    typedef float f32x16 __attribute__((ext_vector_type(16)));
    const bool xmap = gridDim.x == 256;
    const int xwi = ((blockIdx.x & 1) * 32) + (blockIdx.x >> 3);
    for (int ui = 0;; ++ui) {
        int b, qt;
        if (xmap) { if (ui >= 16) break; b = (blockIdx.x & 7) >> 1; qt = 1023 - (((ui & 1) ? 63 - xwi : xwi) + 64 * ui); }
        else { const int unit = blockIdx.x + ui * gridDim.x; if (unit >= NT / 8) break; b = unit & 3; qt = 1023 - (unit >> 2); }
        const int t0 = qt * 8, g0 = b * SEQ + t0;
        const int nkeys = ((t0 + 8 + 511) >> 9) << 9;
        const int nst = nkeys >> 8;
        bf16x8 af[4];
        {
            const int row = l31, q = 2 * rb + (row >> 4), h = row & 15;
            const bf16_t* src = qidx + (size_t)(g0 + q) * 1024 + h * 64 + 8 * hh;
#pragma unroll
            for (int kk = 0; kk < 4; ++kk) af[kk] = *(const bf16x8*)(src + 16 * kk);
        }
        h2_t wq0[4], wq1[4];
#pragma unroll
        for (int i = 0; i < 4; ++i) { const int h = ((2 * i) & 3) + 8 * ((2 * i) >> 2) + 4 * hh;
            wq0[i] = (h2_t){(_Float16)widx[(size_t)(g0 + 2 * rb) * 16 + h], (_Float16)widx[(size_t)(g0 + 2 * rb) * 16 + h + 1]};
            wq1[i] = (h2_t){(_Float16)widx[(size_t)(g0 + 2 * rb + 1) * 16 + h], (_Float16)widx[(size_t)(g0 + 2 * rb + 1) * 16 + h + 1]}; }
        const int myq = t0 + 2 * rb + hh;
        const bf16_t* ksrc = kidx + ((size_t)b * SEQ + drow) * 64 + dchunk * 8;
        LAS u16* scw = sc + (2 * rb + hh) * 2048 + kb * 32 + l31;
        const int t = t0 + wv, n = t + 1;
        const int nch = (n + 511) >> 9;
        const LAS u16* srow = sc + wv * 2048;
        u32x4 kr[16];
#pragma unroll
        for (int ch = 0; ch < 16; ++ch) kr[ch] = (u32x4){0u, 0u, 0u, 0u};
        auto score_pass = [&](const int s0, const int s1) {
            asm volatile("s_waitcnt lgkmcnt(0)" ::: "memory");
            __builtin_amdgcn_s_barrier(); asm volatile("" ::: "memory");
#pragma unroll
            for (int j = 0; j < 4; ++j) __builtin_amdgcn_global_load_lds((const unsigned*)(ksrc + (size_t)(s0 * 4 + j) * 4096), (LAS unsigned*)(kt + j * 8192 + wv * 1024), 16, 0, 0);
#pragma unroll
            for (int j = 0; j < 4; ++j) __builtin_amdgcn_global_load_lds((const unsigned*)(ksrc + (size_t)(s0 * 4 + 4 + j) * 4096), (LAS unsigned*)(kt + 32768 + j * 8192 + wv * 1024), 16, 0, 0);
            if (s0 + 2 < s1) {
#pragma unroll
                for (int j = 0; j < 4; ++j) __builtin_amdgcn_global_load_lds((const unsigned*)(ksrc + (size_t)(s0 * 4 + 8 + j) * 4096), (LAS unsigned*)(kt + 65536 + j * 8192 + wv * 1024), 16, 0, 0);
                asm volatile("s_waitcnt vmcnt(8)" ::: "memory");
            } else asm volatile("s_waitcnt vmcnt(4)" ::: "memory");
            asm volatile("" : "+v"(af[0]), "+v"(af[1]), "+v"(af[2]), "+v"(af[3]));
            asm volatile("" : "+v"(wq0[0]), "+v"(wq0[1]), "+v"(wq0[2]), "+v"(wq0[3]), "+v"(wq1[0]), "+v"(wq1[1]), "+v"(wq1[2]), "+v"(wq1[3]));
            __builtin_amdgcn_s_barrier(); asm volatile("" ::: "memory");
            int slot = 0;
#pragma unroll 1
            for (int st = s0; st < s1; ++st) {
                const int ahead = s1 - 1 - st;
                if (ahead >= 3) { const int ns = (slot + 98304) & 131071;
#pragma unroll
                    for (int j = 0; j < 4; ++j) __builtin_amdgcn_global_load_lds((const unsigned*)(ksrc + (size_t)((st + 3) * 4 + j) * 4096), (LAS unsigned*)(kt + ns + j * 8192 + wv * 1024), 16, 0, 0);
                }
                ldsp_t kb_ = kt + slot;
                const f32x16 zero16 = {0.f, 0.f, 0.f, 0.f, 0.f, 0.f, 0.f, 0.f, 0.f, 0.f, 0.f, 0.f, 0.f, 0.f, 0.f, 0.f};
#define SC_MMA(ACC, j_) do { bf16x8 bq_[4]; _Pragma("unroll") for (int kk = 0; kk < 4; ++kk) bq_[kk] = *(const LAS bf16x8*)(kb_ + (j_) * 8192 + boff[kk]); \
                    asm volatile("" : "+v"(bq_[0]), "+v"(bq_[1]), "+v"(bq_[2]), "+v"(bq_[3]));     \
                    ACC = zero16; _Pragma("unroll") for (int kk = 0; kk < 4; ++kk) ACC = __builtin_amdgcn_mfma_f32_32x32x16_bf16(af[kk], bq_[kk], ACC, 0, 0, 0); } while (0)
#define SC_TILE(ACC, j_) do { float sa = 0.f, sb = 0.f; \
                    _Pragma("unroll") for (int i = 0; i < 4; ++i) { \
                        const s2_t ra = __builtin_elementwise_max(__builtin_bit_cast(s2_t, __builtin_amdgcn_cvt_pkrtz(ACC[2 * i], ACC[2 * i + 1])), (s2_t){0, 0}); \
                        const s2_t rb_ = __builtin_elementwise_max(__builtin_bit_cast(s2_t, __builtin_amdgcn_cvt_pkrtz(ACC[8 + 2 * i], ACC[9 + 2 * i])), (s2_t){0, 0}); \
                        sa = __builtin_amdgcn_fdot2(__builtin_bit_cast(h2_t, ra), wq0[i], sa, false); \
                        sb = __builtin_amdgcn_fdot2(__builtin_bit_cast(h2_t, rb_), wq1[i], sb, false); } \
                    const u32x2 sw = __builtin_amdgcn_permlane32_swap(__float_as_uint(sa), __float_as_uint(sb), false, false); \
                    const float s = __uint_as_float(sw[0]) + __uint_as_float(sw[1]); \
                    const int kidx_ = st * 256 + (j_) * 64 + kb * 32 + l31; \
                    scw[(st - s0) * 256 + (j_) * 64] = (kidx_ <= myq) ? score_key(s) : (unsigned short)0; } while (0)
                f32x16 accA, accB;
                SC_MMA(accA, 0);
                SC_MMA(accB, 1); SC_TILE(accA, 0);
                SC_MMA(accA, 2); SC_TILE(accB, 1);
                SC_MMA(accB, 3); SC_TILE(accA, 2);
                SC_TILE(accB, 3);
#undef SC_MMA
#undef SC_TILE
                slot = (slot + 32768) & 131071;
                if (ahead >= 3) asm volatile("s_waitcnt vmcnt(8) lgkmcnt(0)" ::: "memory");
                else if (ahead == 2) asm volatile("s_waitcnt vmcnt(4) lgkmcnt(0)" ::: "memory");
                else asm volatile("s_waitcnt vmcnt(0) lgkmcnt(0)" ::: "memory");
                __builtin_amdgcn_s_barrier(); asm volatile("" ::: "memory");
            }
        };
#define IDX_PASS(P) if (nst > 8 * (P)) { score_pass(8 * (P), nst < 8 * (P) + 8 ? nst : 8 * (P) + 8); \
            _Pragma("unroll") for (int ch = 4 * (P); ch < 4 * (P) + 4; ++ch) if (ch < nch) kr[ch] = *(const LAS u32x4*)(srow + (ch - 4 * (P)) * 512 + lane * 8); }
        IDX_PASS(0) IDX_PASS(1) IDX_PASS(2) IDX_PASS(3)
#undef IDX_PASS
        if (nsel_rep) {
            u16* sog = sel + (size_t)(g0 + wv) * 256;
            LAS u16* so = (LAS u16*)(kt + wv * 512);
            if (n <= 256) {
#pragma unroll
                for (int i = 0; i < 4; ++i) { const int j = i * 64 + lane; so[j] = (u16)(j < n ? j : 0); }
            } else {
                unsigned T = 0;
#pragma unroll 1
                for (int bit = 15; bit >= 0; --bit) {
                    const unsigned Tc = T | (1u << bit), tm1 = Tc - 1u, tpk = tm1 | (tm1 << 16);
                    unsigned c2 = 0;
#pragma unroll
                    for (int ch = 0; ch < 4; ++ch) c2 = cnt_ge4(c2, kr[ch], tpk);
                    if (nch > 4) {
#pragma unroll
                        for (int ch = 4; ch < 8; ++ch) c2 = cnt_ge4(c2, kr[ch], tpk);
                        if (nch > 8) {
#pragma unroll
                            for (int ch = 8; ch < 12; ++ch) c2 = cnt_ge4(c2, kr[ch], tpk);
                            if (nch > 12) {
#pragma unroll
                                for (int ch = 12; ch < 16; ++ch) c2 = cnt_ge4(c2, kr[ch], tpk);
                            }
                        }
                    }
                    const int cnt = __builtin_amdgcn_readfirstlane(wave_sum_fast((int)(c2 & 0xffffu) + (int)(c2 >> 16)));
                    if (cnt >= TOPK) T = Tc;
                    if (cnt == TOPK) break;
                }
                int base = 0;
                const unsigned long long lt = (1ull << lane) - 1ull;
#pragma unroll
                for (int ch = 0; ch < 16; ++ch) {
                    if (ch < nch) {
#pragma unroll
                        for (int j = 0; j < 8; ++j) {
                            const unsigned d = kr[ch][j >> 1]; const unsigned key = (j & 1) ? (d >> 16) : (d & 0xffffu);
                            const bool gt = key > T;
                            const unsigned long long m = __ballot(gt);
                            if (gt) so[base + __popcll(m & lt)] = (u16)(ch * 512 + lane * 8 + j);
                            base += __popcll(m);
                        }
                    }
                }
                int need = TOPK - base;
#pragma unroll
                for (int ch = 0; ch < 16; ++ch) {
                    if (ch < nch && need > 0) {
                        const unsigned tpk2 = T | (T << 16);
                        bool anyeq = false;
#pragma unroll
                        for (int dq = 0; dq < 4; ++dq) { const unsigned x = kr[ch][dq] ^ tpk2; anyeq |= ((x & 0xffffu) == 0u) | ((x >> 16) == 0u); }
                        if (__ballot(anyeq) == 0ull) continue;
#pragma unroll
                        for (int j = 0; j < 8; ++j) {
                            const unsigned d = kr[ch][j >> 1]; const unsigned key = (j & 1) ? (d >> 16) : (d & 0xffffu);
                            const bool eq = key == T;
                            const unsigned long long m = __ballot(eq);
                            const int rk = __popcll(m & lt);
                            if (eq && rk < need) so[base + rk] = (u16)(ch * 512 + lane * 8 + j);
                            const int tk = __popcll(m); const int took = tk < need ? tk : need;
                            base += took; need -= took;
                        }
                    }
                }
            }
            *(u32x2*)(sog + lane * 4) = *(const LAS u32x2*)(so + lane * 4);
        }
    }
    asm volatile("s_waitcnt vmcnt(0) lgkmcnt(0)" ::: "memory");
    __syncthreads();
    if (opaque_tid() == 0) *(LAS u32x4*)(lds + LDS_BYTES - 16) = (u32x4){bw0, bw1, bw2, bw3};
    __syncthreads();
}

__device__ __forceinline__ unsigned kv_off(unsigned row, unsigned ch) { return 256u * row + 16u * (ch ^ (((row & 3) << 2) | ((row >> 2) & 3))); }
__device__ __forceinline__ void ph_attn(const Params& p, ldsp_t lds) {
    const bf16_t* qlat = (const bf16_t*)(p.ws + O_QLAT); const bf16_t* kv = (const bf16_t*)(p.ws + O_KV); const u16* sel = (const u16*)(p.ws + O_SEL);
    bf16_t* olat = (bf16_t*)(p.ws + O_OLAT);
    const int tid = opaque_tid(), lane = tid & 63, wv = __builtin_amdgcn_readfirstlane(tid >> 6);
    ldsp_t img = lds + wv * 8192;
    LAS u16* selB = (LAS u16*)(lds + 65536 + wv * 1024);
    LAS float* tab = (LAS float*)(lds + 65536 + 8192);
    for (int i = tid; i < 2048; i += NTHREADS) { const int d = i >> 4; int bk; if (d < 16) bk = d; else { bk = 16 + (int)(__log2f((float)d * 0.0625f) * (16.0f / 3.0f)); if (bk > 31) bk = 31; }
        tab[i] = p.rpb[bk * 16 + (i & 15)]; }
    __syncthreads();
    const int hd = lane & 15, g = lane >> 4;
    const bool xmap = gridDim.x == 256;
    const int qstride = xmap ? 512 : (int)gridDim.x * 8;
    const int tok0 = xmap ? (((blockIdx.x & 7) >> 1) * SEQ + (((blockIdx.x & 1) * 32 + (blockIdx.x >> 3)) * 8) + wv) : (int)(blockIdx.x * 8 + wv);
    const int tok_end = xmap ? (((blockIdx.x & 7) >> 1) + 1) * SEQ : NT;
    const int nq = tok0 < tok_end ? (tok_end - tok0 + qstride - 1) / qstride : 0;
    const int nchunks = nq * 8;
    u32x4 stA[8], stB[8];
#define ATT_GATHER(ST, n_) do { const int qi_ = (n_) >> 3, ch_ = (n_) & 7; const int tk_ = tok0 + qi_ * qstride; const bf16_t* kvb_ = kv + (size_t)(tk_ >> 13) * SEQ * 128; \
        _Pragma("unroll") for (int it = 0; it < 8; ++it) { const int pc = it * 64 + lane, r = pc >> 4, c16 = pc & 15; const int ki = selB[(qi_ & 1) * 256 + ch_ * 32 + r]; \
            ST[it] = *(const u32x4*)(kvb_ + (size_t)ki * 128 + c16 * 8); } } while (0)
#define ATT_STAGE(ST) do { _Pragma("unroll") for (int it = 0; it < 8; ++it) { const int pc = it * 64 + lane, r = pc >> 4, c16 = pc & 15; *(LAS u32x4*)(img + kv_off(r, c16)) = ST[it]; } } while (0)
    bf16x8 qf[4];
    if (nq > 0) {
        const u32x2 s4 = *(const u32x2*)(sel + (size_t)tok0 * 256 + lane * 4); *(LAS u32x2*)(selB + lane * 4) = s4;
#pragma unroll
        for (int kk = 0; kk < 4; ++kk) qf[kk] = *(const bf16x8*)(qlat + (size_t)tok0 * 2048 + hd * 128 + 32 * kk + 8 * g);
        ATT_GATHER(stA, 0); ATT_GATHER(stB, 1);
    }
#pragma unroll 1
    for (int qi = 0; qi < nq; ++qi) {
        const int tok = tok0 + qi * qstride, t = tok & (SEQ - 1);
        const int nsel = (t + 1) < TOPK ? (t + 1) : TOPK;
        const int buf = qi & 1;
        const int tokn = (qi + 1 < nq) ? tok + qstride : tok;
        const u32x2 sn = *(const u32x2*)(sel + (size_t)tokn * 256 + lane * 4);
        bf16x8 qn[4];
#pragma unroll
        for (int kk = 0; kk < 4; ++kk) qn[kk] = *(const bf16x8*)(qlat + (size_t)tokn * 2048 + hd * 128 + 32 * kk + 8 * g);
        f32x4 o[8];
#pragma unroll
        for (int mb = 0; mb < 8; ++mb) o[mb] = (f32x4){0.f, 0.f, 0.f, 0.f};
        float mrun = -1e30f, lrun = 0.f;
        auto compute = [&](const int ch) {
            float bias[2][4];
#pragma unroll
            for (int blk = 0; blk < 2; ++blk) {
                const u32x2 k4 = *(const LAS u32x2*)(selB + buf * 256 + ch * 32 + 16 * blk + 4 * g);
#pragma unroll
                for (int r = 0; r < 4; ++r) {
                    const int pos = ch * 32 + 16 * blk + 4 * g + r;
                    const int ki = (int)(((r & 2) ? k4.y : k4.x) >> ((r & 1) * 16)) & 0xffff;
                    int dist = t - ki; dist = dist < 0 ? 0 : (dist > 127 ? 127 : dist);
                    float tv = tab[dist * 16 + hd]; asm volatile("" : "+v"(tv));
                    bias[blk][r] = (pos < nsel) ? tv : -1e30f;
                }
            }
            f32x4 s[2];
#pragma unroll
            for (int blk = 0; blk < 2; ++blk) {
                s[blk] = (f32x4){0.f, 0.f, 0.f, 0.f};
#pragma unroll
                for (int kk = 0; kk < 4; ++kk) {
                    const bf16x8 a = *(const LAS bf16x8*)(img + kv_off(hd + 16 * blk, 4 * kk + g));
                    s[blk] = __builtin_amdgcn_mfma_f32_16x16x32_bf16(a, qf[kk], s[blk], 0, 0, 0);
                }
            }
            float mx = -1e30f;
#pragma unroll
            for (int blk = 0; blk < 2; ++blk)
#pragma unroll
                for (int r = 0; r < 4; ++r) { const float v = s[blk][r] + bias[blk][r]; s[blk][r] = v; mx = fmaxf(mx, v); }
            { u32x2 rr = __builtin_amdgcn_permlane16_swap(__float_as_uint(mx), __float_as_uint(mx), false, false); mx = fmaxf(__uint_as_float(rr[0]), __uint_as_float(rr[1]));
              rr = __builtin_amdgcn_permlane32_swap(__float_as_uint(mx), __float_as_uint(mx), false, false); mx = fmaxf(__uint_as_float(rr[0]), __uint_as_float(rr[1])); }
            const float mnew = fmaxf(mrun, mx), scl = __expf(mrun - mnew);
            float ps = 0.f;
#pragma unroll
            for (int blk = 0; blk < 2; ++blk)
#pragma unroll
                for (int r = 0; r < 4; ++r) { const float e = __expf(s[blk][r] - mnew); s[blk][r] = e; ps += e; }
            { u32x2 rr = __builtin_amdgcn_permlane16_swap(__float_as_uint(ps), __float_as_uint(ps), false, false); ps = __uint_as_float(rr[0]) + __uint_as_float(rr[1]);
              rr = __builtin_amdgcn_permlane32_swap(__float_as_uint(ps), __float_as_uint(ps), false, false); ps = __uint_as_float(rr[0]) + __uint_as_float(rr[1]); }
            lrun = lrun * scl + ps; mrun = mnew;
#pragma unroll
            for (int mb = 0; mb < 8; ++mb) o[mb] *= scl;
            bf16x8 pf;
            { const u32x4 w = (u32x4){pk_bf16(s[0][0], s[0][1]), pk_bf16(s[0][2], s[0][3]), pk_bf16(s[1][0], s[1][1]), pk_bf16(s[1][2], s[1][3])}; pf = __builtin_bit_cast(bf16x8, w); }
#pragma unroll
            for (int mb = 0; mb < 8; ++mb) {
                const unsigned qq = (lane & 15) >> 2, pp = lane & 3;
                const unsigned a0 = kv_off(4 * g + qq, 2 * mb + (pp >> 1)) + 8 * (pp & 1);
                const unsigned a1 = kv_off(16 + 4 * g + qq, 2 * mb + (pp >> 1)) + 8 * (pp & 1);
                const s16x4 t0_ = __builtin_amdgcn_ds_read_tr16_b64_v4i16((LAS s16x4*)(img + a0));
                const s16x4 t1_ = __builtin_amdgcn_ds_read_tr16_b64_v4i16((LAS s16x4*)(img + a1));
                const bf16x8 af = (bf16x8){t0_[0], t0_[1], t0_[2], t0_[3], t1_[0], t1_[1], t1_[2], t1_[3]};
                o[mb] = __builtin_amdgcn_mfma_f32_16x16x32_bf16(af, pf, o[mb], 0, 0, 0);
            }
        };
#pragma unroll
        for (int ch = 0; ch < 8; ch += 2) {
            const int n = qi * 8 + ch;
            if (ch == 4) *(LAS u32x2*)(selB + (buf ^ 1) * 256 + lane * 4) = sn;
            ATT_STAGE(stA);
            if (n + 2 < nchunks) ATT_GATHER(stA, n + 2);
            compute(ch);
            ATT_STAGE(stB);
            if (n + 3 < nchunks) ATT_GATHER(stB, n + 3);
            compute(ch + 1);
        }
        const float inv = OSCALE / lrun;
        unsigned w8[8];
#pragma unroll
        for (int mb = 0; mb < 8; ++mb) {
            int w = 0; w = __builtin_amdgcn_cvt_pk_fp8_f32(o[mb][0] * inv, o[mb][1] * inv, w, false); w = __builtin_amdgcn_cvt_pk_fp8_f32(o[mb][2] * inv, o[mb][3] * inv, w, true); w8[mb] = (unsigned)w; }
        *(u32x4*)((unsigned char*)olat + (size_t)tok * 3072 + hd * 128 + g * 32) = (u32x4){w8[0], w8[1], w8[2], w8[3]};
        *(u32x4*)((unsigned char*)olat + (size_t)tok * 3072 + hd * 128 + g * 32 + 16) = (u32x4){w8[4], w8[5], w8[6], w8[7]};
#pragma unroll
        for (int kk = 0; kk < 4; ++kk) qf[kk] = qn[kk];
    }
#undef ATT_GATHER
#undef ATT_STAGE
    __syncthreads();
}
namespace hg {
constexpr int L_QT = 0, L_KT = 4096, L_KHT = 8192, L_VT = 16384, L_DV = 24576, L_ATT = 25088, L_SSQ = 33280, L_RAW = 33792, L_END = L_RAW + 2 * 12288;
__device__ __forceinline__ unsigned off16(unsigned row, unsigned ch) { return 256u * row + 16u * (ch ^ (((row & 3) << 2) | ((row >> 2) & 3))); }
__device__ __forceinline__ unsigned offT(unsigned row, unsigned ch) { return 64u * row + 16u * (ch ^ ((row >> 2) & 3)); }

template <int PASS>
__device__ __forceinline__ void run(const Params& p, ldsp_t lds) {
    const _Float16* LF = (const _Float16*)(p.ws + O_LF); const bf16_t* QB = (const bf16_t*)(p.ws + O_QB); const bf16_t* VV = (const bf16_t*)(p.ws + O_V); const bf16_t* GG = (const bf16_t*)(p.ws + O_G);
    float* HST = (float*)(p.ws + O_HST); float* HDEC = (float*)(p.ws + O_HDEC); bf16_t* OB = (bf16_t*)(p.ws + O_OLAT);
    const int tid = opaque_tid(), lane = tid & 63, wv = __builtin_amdgcn_readfirstlane(tid >> 6);
    const int l15 = lane & 15, g = lane >> 4;
    const int k = tid & 127, ig = tid >> 7;
    for (int i = tid; i < (L_ATT + 8192 - L_KHT) / 16; i += NTHREADS) *(LAS u32x4*)(lds + L_KHT + i * 16) = (u32x4){0u, 0u, 0u, 0u};
    __syncthreads();
    for (int s = blockIdx.x; s < 256; s += gridDim.x) {
        const int seg = s & 7, h = (s >> 3) & 7, b = s >> 6;
        if (PASS == 1 && seg == 7) continue;
        const size_t tok0 = (size_t)b * SEQ + (size_t)seg * HSEGL;
        const size_t cbase = (size_t)h * 128;
        f32x4 S[8];
#pragma unroll
        for (int mb = 0; mb < 8; ++mb) S[mb] = (f32x4){0.f, 0.f, 0.f, 0.f};
        if (PASS == 3) {
#pragma unroll 2
            for (int gp = 0; gp < seg; ++gp) {
                const int sp = (s & ~7) + gp;
                const float* Lp = HST + ((size_t)sp * 512 + tid) * 32; const float* Dp = HDEC + (size_t)sp * 128 + 4 * g;
#pragma unroll
                for (int mb = 0; mb < 8; ++mb) S[mb] = S[mb] * *(const f32x4*)(Dp + 16 * mb) + *(const f32x4*)(Lp + 4 * mb);
            }
        }
        float lfsum = 0.f;
        const float gn = (PASS == 3) ? p.hong[16 * wv + l15] : 0.f;
        const int rrow = tid >> 5, rc4 = (tid & 31) * 4;
        const unsigned goff0 = (unsigned)(rrow * 1024 + rc4);
        const _Float16* lfb = LF + tok0 * 1024 + cbase; const bf16_t* vbp = VV + tok0 * 1024 + cbase; const bf16_t* qbp = QB + tok0 * 1024 + cbase;
        const unsigned rawo = (unsigned)(rrow * 256 + rc4 * 2);
        u32x2 rl, rv, rq = (u32x2){0u, 0u};
        rl = *(const u32x2*)(lfb + goff0); rv = *(const u32x2*)(vbp + goff0); if (PASS == 3) rq = *(const u32x2*)(qbp + goff0);
        __syncthreads();
        *(LAS u32x2*)(lds + L_RAW + rawo) = rl; *(LAS u32x2*)(lds + L_RAW + 4096 + rawo) = rv; if (PASS == 3) *(LAS u32x2*)(lds + L_RAW + 8192 + rawo) = rq;
        rl = *(const u32x2*)(lfb + goff0 + 16 * 1024); rv = *(const u32x2*)(vbp + goff0 + 16 * 1024); if (PASS == 3) rq = *(const u32x2*)(qbp + goff0 + 16 * 1024);
        __syncthreads();
#pragma unroll 1
        for (int mc = 0; mc < HSEGL / 16; ++mc) {
            const size_t tb = tok0 + (size_t)mc * 16;
            bf16_t gq[4] = {0, 0, 0, 0};
            if (PASS == 3) {
#pragma unroll
                for (int r = 0; r < 4; ++r) gq[r] = GG[(tb + 4 * g + r) * 1024 + cbase + 16 * wv + l15];
            }
            {
                ldsp_t raw = lds + L_RAW + (mc & 1) * 12288;
                float btot = 0.f, bpre = 0.f;
#pragma unroll
                for (int i = 0; i < 16; ++i) { const float x = (float)*(const LAS _Float16*)(raw + i * 256 + k * 2); btot += x; bpre += (i < 4 * ig) ? x : 0.f; }
                lfsum += btot;
                unsigned khp[2], vtp[2];
                float bi = bpre;
#pragma unroll
                for (int i = 0; i < 4; ++i) {
                    const int ti = 4 * ig + i;
                    const float lfi = (float)*(const LAS _Float16*)(raw + (4 * ig + i) * 256 + k * 2);
                    bi += lfi;
                    const float kk_ = 1.0f - __expf(lfi);
                    const float kh = kk_ * __expf(btot - bi);
                    if (PASS == 3) {
                        const float qt = bf2f(*(const LAS bf16_t*)(raw + 8192 + (4 * ig + i) * 256 + k * 2)) * __expf(bi);
                        const float kt = kk_ * __expf(fminf(-bi, 85.0f));
                        *(LAS bf16_t*)(lds + L_QT + off16(ti, k >> 3) + (k & 7) * 2) = f2bf(qt);
                        *(LAS bf16_t*)(lds + L_KT + off16(ti, k >> 3) + (k & 7) * 2) = f2bf(kt);
                    }
                    const unsigned khb = f2bf(kh), vb_ = *(const LAS bf16_t*)(raw + 4096 + (4 * ig + i) * 256 + k * 2);
                    if (i & 1) { khp[i >> 1] |= khb << 16; vtp[i >> 1] |= vb_ << 16; } else { khp[i >> 1] = khb; vtp[i >> 1] = vb_; }
                }
                *(LAS u32x2*)(lds + L_KHT + offT(k, ig >> 1) + 8 * (ig & 1)) = (u32x2){khp[0], khp[1]};
                *(LAS u32x2*)(lds + L_VT + offT(k, ig >> 1) + 8 * (ig & 1)) = (u32x2){vtp[0], vtp[1]};
                if (ig == 0) *(LAS float*)(lds + L_DV + k * 4) = __expf(btot);
            }
            __syncthreads();
            const bf16x8 vb = *(const LAS bf16x8*)(lds + L_VT + offT(16 * wv + l15, g));
            f32x4 o = (f32x4){0.f, 0.f, 0.f, 0.f};
            if (PASS == 3) {
                f32x4 att = (f32x4){0.f, 0.f, 0.f, 0.f};
#pragma unroll
                for (int kk = 0; kk < 4; ++kk) {
                    const bf16x8 a = *(const LAS bf16x8*)(lds + L_QT + off16(l15, 4 * kk + g));
                    const bf16x8 bb = *(const LAS bf16x8*)(lds + L_KT + off16(l15, 4 * kk + g));
                    att = __builtin_amdgcn_mfma_f32_16x16x32_bf16(a, bb, att, 0, 0, 0);
                }
                ldsp_t al_ = lds + L_ATT + wv * 1024;
#pragma unroll
                for (int r = 0; r < 4; ++r) { const int t = 4 * g + r; const float v = (l15 <= t) ? att[r] : 0.f; *(LAS bf16_t*)(al_ + t * 64 + l15 * 2) = f2bf(v); }
#pragma unroll
                for (int kk = 0; kk < 4; ++kk) {
                    const u32x2 q0 = *(const LAS u32x2*)(lds + L_QT + off16(l15, 4 * kk + (g >> 1)) + 8 * (g & 1));
                    const u32x2 q1 = *(const LAS u32x2*)(lds + L_QT + off16(l15, 4 * kk + 2 + (g >> 1)) + 8 * (g & 1));
                    const u32x4 aw = (u32x4){q0.x, q0.y, q1.x, q1.y};
                    const u32x4 sw = (u32x4){pk_bf16(S[2 * kk][0], S[2 * kk][1]), pk_bf16(S[2 * kk][2], S[2 * kk][3]), pk_bf16(S[2 * kk + 1][0], S[2 * kk + 1][1]), pk_bf16(S[2 * kk + 1][2], S[2 * kk + 1][3])};
                    o = __builtin_amdgcn_mfma_f32_16x16x32_bf16(__builtin_bit_cast(bf16x8, aw), __builtin_bit_cast(bf16x8, sw), o, 0, 0, 0);
                }
                const bf16x8 aa = *(const LAS bf16x8*)(al_ + l15 * 64 + g * 16);
                o = __builtin_amdgcn_mfma_f32_16x16x32_bf16(aa, vb, o, 0, 0, 0);
            }
#pragma unroll
            for (int mb = 0; mb < 8; ++mb) {
                const f32x4 dv = *(const LAS f32x4*)(lds + L_DV + (16 * mb + 4 * g) * 4);
                const bf16x8 a = *(const LAS bf16x8*)(lds + L_KHT + offT(16 * mb + l15, g));
                S[mb] = __builtin_amdgcn_mfma_f32_16x16x32_bf16(a, vb, S[mb] * dv, 0, 0, 0);
            }
            {
                ldsp_t rn = lds + L_RAW + ((mc + 1) & 1) * 12288;
                *(LAS u32x2*)(rn + rawo) = rl; *(LAS u32x2*)(rn + 4096 + rawo) = rv; if (PASS == 3) *(LAS u32x2*)(rn + 8192 + rawo) = rq;
                if (mc + 2 < HSEGL / 16) { const unsigned go = goff0 + (unsigned)(mc + 2) * 16 * 1024;
                    rl = *(const u32x2*)(lfb + go); rv = *(const u32x2*)(vbp + go); if (PASS == 3) rq = *(const u32x2*)(qbp + go); }
            }
            if (PASS == 3) {
#pragma unroll
                for (int r = 0; r < 4; ++r) { float q = o[r] * o[r]; q += DPPF(q, 0xB1); q += DPPF(q, 0x4E); q += DPPF(q, 0x141); q += DPPF(q, 0x140);
                    if (l15 == 0) *(LAS float*)(lds + L_SSQ + ((4 * g + r) * 8 + wv) * 4) = q; }
            }
            __syncthreads();
            if (PASS == 3) {
#pragma unroll
                for (int r = 0; r < 4; ++r) {
                    const int t = 4 * g + r;
                    const f32x4 s0 = *(const LAS f32x4*)(lds + L_SSQ + t * 32), s1 = *(const LAS f32x4*)(lds + L_SSQ + t * 32 + 16);
                    const float tot = ((s0[0] + s0[1]) + (s0[2] + s0[3])) + ((s1[0] + s1[1]) + (s1[2] + s1[3]));
                    const float rstd = rsqrtf(tot * (1.0f / 128.0f) + LN_EPS);
                    const size_t gi = (tb + t) * 1024 + cbase + 16 * wv + l15;
                    ((unsigned char*)OB)[(tb + t) * 3072 + 2048 + cbase + 16 * wv + l15] = f2fp8(o[r] * rstd * gn * bf2f(gq[r]) * OSCALE);
                }
            }
        }
        if (PASS == 1) {
            float* Lp = HST + ((size_t)s * 512 + tid) * 32;
#pragma unroll
            for (int mb = 0; mb < 8; ++mb) *(f32x4*)(Lp + 4 * mb) = S[mb];
            if (ig == 0) HDEC[(size_t)s * 128 + k] = __expf(lfsum);
        }
        __syncthreads();
    }
}
}
__device__ __forceinline__ void ph_ln1(const Params& p, ldsp_t lds) {
    const float* mod = (const float*)(p.ws + O_MOD);
    bf16_t* h2 = (bf16_t*)(p.ws + O_H2); const bf16_t* r16 = (const bf16_t*)(p.ws + O_R16); unsigned char* h28 = p.ws + O_H28; bf16_t* t16 = (bf16_t*)(p.ws + O_T16);
    const int tid_ = opaque_tid(); const int lane = tid_ & 63, wv = tid_ >> 6;
    const bool bmap = gridDim.x == 256;
    const int row0 = bmap ? ((int)(blockIdx.x & 3) * SEQ + (int)(blockIdx.x >> 2) * 8 + wv) : (int)blockIdx.x * 8 + wv;
    const int rstride = bmap ? 512 : (int)gridDim.x * 8, rend = bmap ? ((int)(blockIdx.x & 3) + 1) * SEQ : NT;
    LAS float* pg = (LAS float*)lds; LAS float* pb = pg + 2048; LAS float* psh = pg + 4096; LAS float* psc = pg + 6144;
    __syncthreads();
    for (int i = tid_; i < 2048; i += NTHREADS) { pg[i] = p.ln1g[i]; pb[i] = p.ln1b[i]; }
    if (bmap) { const int b = blockIdx.x & 3; for (int i = tid_; i < 2048; i += NTHREADS) { psh[i] = mod[b * 12288 + 3 * 2048 + i]; psc[i] = mod[b * 12288 + 4 * 2048 + i] + 1.0f; } }
    else { for (int i = tid_; i < 4 * 2048; i += NTHREADS) { const int b = i >> 11, c = i & 2047; psh[8192 + b * 4096 + c] = mod[b * 12288 + 3 * 2048 + c]; psh[8192 + b * 4096 + 2048 + c] = mod[b * 12288 + 4 * 2048 + c] + 1.0f; } }
    __syncthreads();
    u32x4 gn[4];
    if (row0 < rend) {
#pragma unroll
        for (int i = 0; i < 4; ++i) gn[i] = *(const u32x4*)(r16 + (size_t)row0 * 2048 + (i * 64 + lane) * 8);
    }
#pragma unroll 1
    for (int row = row0; row < rend; row += rstride) {
        const LAS float* sh = bmap ? psh : psh + 8192 + (row >> 13) * 4096; const LAS float* sc = bmap ? psc : sh + 2048;
        f32x4 v[8]; float s = 0.f;
#pragma unroll
        for (int i = 0; i < 4; ++i) {
            const u32x4 g = gn[i];
            v[2 * i] = (f32x4){__uint_as_float(g.x << 16), __uint_as_float(g.x & 0xffff0000u), __uint_as_float(g.y << 16), __uint_as_float(g.y & 0xffff0000u)};
            v[2 * i + 1] = (f32x4){__uint_as_float(g.z << 16), __uint_as_float(g.z & 0xffff0000u), __uint_as_float(g.w << 16), __uint_as_float(g.w & 0xffff0000u)};
        }
        { const int rn = (row + rstride < rend) ? row + rstride : row;
#pragma unroll
          for (int i = 0; i < 4; ++i) gn[i] = *(const u32x4*)(r16 + (size_t)rn * 2048 + (i * 64 + lane) * 8); }
#pragma unroll
        for (int i = 0; i < 8; ++i) s += (v[i][0] + v[i][1]) + (v[i][2] + v[i][3]);
        float mu = wave_sum(s) * (1.0f / 2048.0f);
        float q = 0.f;
#pragma unroll
        for (int i = 0; i < 8; ++i) { v[i] -= mu; q += (v[i][0] * v[i][0] + v[i][1] * v[i][1]) + (v[i][2] * v[i][2] + v[i][3] * v[i][3]); }
        float rstd = rsqrtf(wave_sum(q) * (1.0f / 2048.0f) + LN_EPS);
        s = 0.f;
#pragma unroll
        for (int i = 0; i < 8; ++i) {
            const int col = ((i >> 1) * 64 + lane) * 8 + (i & 1) * 4;
            v[i] = v[i] * rstd * *(const LAS f32x4*)(pg + col) + *(const LAS f32x4*)(pb + col);
            s += (v[i][0] + v[i][1]) + (v[i][2] + v[i][3]);
        }
#pragma unroll
        for (int i = 0; i < 4; ++i) st8_bf16(t16 + (size_t)row * 2048 + (i * 64 + lane) * 8, v[2 * i], v[2 * i + 1]);
        mu = wave_sum(s) * (1.0f / 2048.0f); q = 0.f;
#pragma unroll
        for (int i = 0; i < 8; ++i) { v[i] -= mu; q += (v[i][0] * v[i][0] + v[i][1] * v[i][1]) + (v[i][2] * v[i][2] + v[i][3] * v[i][3]); }
        rstd = rsqrtf(wave_sum(q) * (1.0f / 2048.0f) + LN_EPS);
#pragma unroll
        for (int i = 0; i < 4; ++i) {
            const int col = (i * 64 + lane) * 8;
            const f32x4 sh0 = *(const LAS f32x4*)(sh + col), sh1 = *(const LAS f32x4*)(sh + col + 4);
            const f32x4 sc0 = *(const LAS f32x4*)(sc + col), sc1 = *(const LAS f32x4*)(sc + col + 4);
            const f32x4 y0 = v[2 * i] * rstd * sc0 + sh0, y1 = v[2 * i + 1] * rstd * sc1 + sh1;
            st8_bf16(h2 + (size_t)row * 2048 + col, y0, y1);
            *(u32x2*)(h28 + (size_t)row * 2048 + col) = pk8_fp8(y0, y1);
        }
    }
    __syncthreads();
}

__device__ __forceinline__ void route_block(const Params& p, ldsp_t lds, const int t0, const int nt) {
    const float* logit = (const float*)(p.ws + O_LOGIT);
    int* rsel = (int*)(p.ws + O_RSEL); float* rw = (float*)(p.ws + O_RW); int* cnt = (int*)(p.ws + O_CNT);
    LAS float* sb = (LAS float*)lds;
    LAS int* hist = (LAS int*)(lds + 512 * 65 * 4);
    const int tid = opaque_tid();
    const bool act = tid < nt;
    const int tok = t0 + (act ? tid : 0), chunk = t0 / CHTOK;
    __syncthreads();
    if (tid < 64) hist[tid] = 0;
    LAS float* my = sb + tid * 65;
    if (act) {
#pragma unroll 4
        for (int e = 0; e < 64; e += 4) { const f32x4 l = *(const f32x4*)(logit + (size_t)tok * 64 + e);
#pragma unroll
            for (int j = 0; j < 4; ++j) my[e + j] = sigmoidf_(l[j]) + p.rbias[e + j]; }
    }
    __syncthreads();
    if (act) {
        float gs[8];
#pragma unroll
        for (int gI = 0; gI < 8; ++gI) { float m1 = -1e30f, m2 = -1e30f;
#pragma unroll
            for (int j = 0; j < 8; ++j) { const float v = my[gI * 8 + j]; if (v > m1) { m2 = m1; m1 = v; } else if (v > m2) m2 = v; }
            gs[gI] = m1 + m2; }
        unsigned gmask = 0;
#pragma unroll
        for (int r = 0; r < 4; ++r) { float best = -1e30f; int bi = 0;
#pragma unroll
            for (int gI = 0; gI < 8; ++gI) { const bool ok = !((gmask >> gI) & 1u) && gs[gI] > best; if (ok) { best = gs[gI]; bi = gI; } }
            gmask |= 1u << bi; }
        int se[8]; float sw[8]; float wsum = 0.f;
        unsigned long long taken = 0ull;
#pragma unroll
        for (int r = 0; r < 8; ++r) { float best = -1e30f; int bi = 0;
            for (int e = 0; e < 64; ++e) { const bool ok = ((gmask >> (e >> 3)) & 1u) && !((taken >> e) & 1ull); const float v = my[e]; if (ok && v > best) { best = v; bi = e; } }
            taken |= 1ull << bi; se[r] = bi; const float sc = my[bi] - p.rbias[bi]; sw[r] = sc; wsum += sc; }
        const float inv = 2.5f / wsum;
#pragma unroll
        for (int r = 0; r < 8; ++r) { rsel[(size_t)tok * 8 + r] = se[r]; rw[(size_t)tok * 8 + r] = sw[r] * inv; atomicAdd((int*)&hist[se[r]], 1); }
    }
    __syncthreads();
    if (tid < 64) atomicAdd(&cnt[chunk * 256 + tid], hist[tid]);
}
__device__ __forceinline__ void ph_route(const Params& p, ldsp_t lds) {
    for (int t0 = blockIdx.x * NTHREADS; t0 < NT; t0 += gridDim.x * NTHREADS) route_block(p, lds, t0, NTHREADS);
    __syncthreads();
}
__device__ __forceinline__ void ph_slots(const Params& p, ldsp_t lds) {
    const int* rsel = (const int*)(p.ws + O_RSEL); const float* rw = (const float*)(p.ws + O_RW); int* cnt = (int*)(p.ws + O_CNT);
    int* tstart = (int*)(p.ws + O_TSTART); int* tilee = (int*)(p.ws + O_TILEE);
    int* tokof = (int*)(p.ws + O_TOKOF); u32x2* wd = (u32x2*)(p.ws + O_WOF);
    LAS int* ts = (LAS int*)lds;
    const int tid = opaque_tid();
    __syncthreads();
    if (tid < NCHUNK) { int acc = 0; for (int e = 0; e < 64; ++e) { ts[tid * 66 + e] = acc; acc += (cnt[tid * 256 + e] + 255) >> 8; } ts[tid * 66 + 64] = acc; ts[tid * 66 + 65] = acc + CHTOK / 256; }
    __syncthreads();
    if (blockIdx.x == 0) {
        for (int i = tid; i < NCHUNK * 66; i += NTHREADS) tstart[(i / 66) * 128 + (i % 66)] = ts[i];
        for (int i = tid; i < NCHUNK * MAXTILES; i += NTHREADS) { const int c = i / MAXTILES, t = i % MAXTILES; int e = 0; for (int q = 0; q < 65; ++q) if (t >= ts[c * 66 + q]) e = q; tilee[c * MAXTILES + t] = e; }
    }
    for (int tok = blockIdx.x * NTHREADS + tid; tok < NT; tok += gridDim.x * NTHREADS) {
        const int c = tok / CHTOK, tl = tok % CHTOK;
#pragma unroll
        for (int r = 0; r < 8; ++r) {
            const int e = rsel[(size_t)tok * 8 + r];
            const int rank = atomicAdd(&cnt[c * 256 + 128 + e], 1);
            const int slot = ts[c * 66 + e] * 256 + rank;
            tokof[c * MAXSLOTS + slot] = tok; wd[c * MAXSLOTS + slot] = (u32x2){__float_as_uint(rw[(size_t)tok * 8 + r]), (unsigned)(tl * 8 + r)};
        }
        const int slot = ts[c * 66 + 64] * 256 + tl;
        tokof[c * MAXSLOTS + slot] = tok; wd[c * MAXSLOTS + slot] = (u32x2){__float_as_uint(1.0f), (unsigned)tok};
    }
    for (int i = blockIdx.x * NTHREADS + tid; i < NCHUNK * 64 * 256; i += gridDim.x * NTHREADS) {
        const int c = i >> 14, e = (i >> 8) & 63, j = i & 255;
        const int n = cnt[c * 256 + e], pad = ((n + 255) & ~255) - n;
        if (j < pad) { const int slot = ts[c * 66 + e] * 256 + n + j; tokof[c * MAXSLOTS + slot] = c * CHTOK; wd[c * MAXSLOTS + slot] = (u32x2){0u, 0xffffffffu}; }
    }
    __syncthreads();
}
__device__ __forceinline__ int exp1_units_of(int wg, int ntiles, int G) {
    if (G == 256) { const int rem = ntiles - 8 * (wg & 7) - ((wg >> 3) & 7); return rem > 0 ? (rem + 63) >> 6 : 0; }
    const int tot = ntiles * 4; return tot > wg ? (tot - wg + G - 1) / G : 0;
}
__device__ __forceinline__ void ph_combine(const Params& p, ldsp_t lds, int chunk) {
    const float* mod = (const float*)(p.ws + O_MOD); const unsigned char* Y = p.ws + O_Y; const bf16_t* t16 = (const bf16_t*)(p.ws + O_H2);
    const int tid_ = opaque_tid(); const int lane0 = tid_ & 63, wv = tid_ >> 6;
    LAS float* pg2 = (LAS float*)lds; LAS float* pg = pg2 + (CHTOK / SEQ) * 2048; LAS float* pb = pg + 2048;
    __syncthreads();
    for (int i = tid_; i < (CHTOK / SEQ) * 2048; i += NTHREADS) pg2[i] = mod[(chunk * (CHTOK / SEQ) + (i >> 11)) * 12288 + 5 * 2048 + (i & 2047)] * (1.0f / YSCALE);
    for (int i = tid_; i < 2048; i += NTHREADS) { pg[i] = p.ln2g[i]; pb[i] = p.ln2b[i]; }
    __syncthreads();
#pragma unroll 1
    for (int tl = blockIdx.x * 8 + wv; tl < CHTOK; tl += gridDim.x * 8) {
        const int row = chunk * CHTOK + tl;
        const LAS float* g2p = pg2 + (tl >> 13) * 2048;
        int lane = lane0; asm volatile("" : "+v"(lane));
        float* xr = p.out + (size_t)row * 2048;
        f32x4 a[8];
#pragma unroll
        for (int i = 0; i < 8; ++i) a[i] = (f32x4){0.f, 0.f, 0.f, 0.f};
#pragma unroll 4
        for (int j = 0; j < 8; ++j) {
            const unsigned char* yr = Y + ((size_t)tl * 8 + j) * 2048;
#pragma unroll
            for (int i = 0; i < 2; ++i) {
                const u32x4 g = *(const u32x4*)(yr + (i * 64 + lane) * 16);
#pragma unroll
                for (int qd = 0; qd < 4; ++qd) {
                    const f32x2 lo = __builtin_amdgcn_cvt_pk_f32_fp8((int)g[qd], false), hi = __builtin_amdgcn_cvt_pk_f32_fp8((int)g[qd], true);
                    a[4 * i + qd][0] += lo[0]; a[4 * i + qd][1] += lo[1]; a[4 * i + qd][2] += hi[0]; a[4 * i + qd][3] += hi[1];
                }
            }
        }
        float s = 0.f;
#pragma unroll
        for (int i = 0; i < 8; ++i) {
            const int sp = ((i >> 2) * 64 + lane) * 16;
            const int col = (sp & ~255) + ((sp & 255) >> 6) * 32 + ((sp & 63) >> 4) * 8 + ((i & 3) >> 1) * 128 + (i & 1) * 4;
            const f32x4 g2 = *(const LAS f32x4*)(g2p + col);
            const u32x2 tt = *(const u32x2*)(t16 + (size_t)row * 2048 + col);
            a[i] = (f32x4){__uint_as_float(tt.x << 16), __uint_as_float(tt.x & 0xffff0000u), __uint_as_float(tt.y << 16), __uint_as_float(tt.y & 0xffff0000u)} + g2 * a[i];
            s += (a[i][0] + a[i][1]) + (a[i][2] + a[i][3]);
        }
        const float mu = wave_sum(s) * (1.0f / 2048.0f);
        float q = 0.f;
#pragma unroll
        for (int i = 0; i < 8; ++i) { a[i] -= mu; q += (a[i][0] * a[i][0] + a[i][1] * a[i][1]) + (a[i][2] * a[i][2] + a[i][3] * a[i][3]); }
        const float rstd = rsqrtf(wave_sum(q) * (1.0f / 2048.0f) + LN_EPS);
#pragma unroll
        for (int i = 0; i < 8; ++i) {
            const int sp = ((i >> 2) * 64 + lane) * 16;
            const int col = (sp & ~255) + ((sp & 255) >> 6) * 32 + ((sp & 63) >> 4) * 8 + ((i & 3) >> 1) * 128 + (i & 1) * 4;
            *(f32x4*)(xr + col) = a[i] * rstd * *(const LAS f32x4*)(pg + col) + *(const LAS f32x4*)(pb + col);
        }
    }
    __syncthreads();
}
#ifndef PROBE
#define PROBE 0
#endif
#define REP(n) for (int rep_ = 0; rep_ < p.rep[n]; ++rep_)
#define GBAR do { xcd_barrier(bar); for (int xr_ = 0; xr_ < p.rep[1]; ++xr_) xcd_barrier(bar); } while (0)
__global__ __launch_bounds__(512, 2) void mega(Params p) {
    extern __shared__ __attribute__((aligned(16))) unsigned char shm_[];
    ldsp_t lds = (ldsp_t)shm_;
    volatile LAS unsigned* st = (volatile LAS unsigned*)(lds + LDS_BYTES - 16);
    if (threadIdx.x == 0) { st[0] = 0u; st[1] = 0u; st[2] = 0u; st[3] = 0u; }
    __syncthreads();
    XcdBarrier bar = xcd_barrier_post((unsigned*)(p.ws + O_BAR), st);
    unsigned char* ws = p.ws;
    _Pragma("unroll 1") REP(8) { ph_conv_small(p, lds); ph_mod(p, lds);
    GBAR;
    ph_lnmod(p, lds);
    GBAR; }
    _Pragma("unroll 1") REP(12) { EpiInProj<false> e; e.ws = ws; gm::gemm_phase(lds, dense<3>(ws + O_HN, 2048, ws + O_BTIN, 2048), e, 2048); }
    _Pragma("unroll 1") REP(19) { EpiInProj<true> e; e.ws = ws; gm::gemm_phase(lds, dense<32>(ws + O_H8, 1024, ws + O_BTIN8, 1024), e, 1024); }
    GBAR;
    _Pragma("unroll 1") REP(9) { ph_smallnorm(p); hg::run<1>(p, lds); }
    GBAR;
    _Pragma("unroll 1") REP(11) { EpiQ e; e.ws = ws; gm::gemm_phase(lds, dense<12>(ws + O_CQN, 512, ws + O_BTQ, 512), e, 512); }
    GBAR;
    _Pragma("unroll 1") REP(2) ph_indexer(p, lds, rep_ == 0 ? 1 : p.rep[13]);
    GBAR;
    _Pragma("unroll 1") REP(3) ph_attn(p, lds);
    _Pragma("unroll 1") REP(6) hg::run<3>(p, lds);
    GBAR;
    {
    _Pragma("unroll 1") REP(7) { EpiMergeA e; e.ws = ws; e.m1 = (bf16_t*)p.out; gm::gemm_phase(lds, dense<8>(ws + O_OLAT, 1536, ws + O_BTAB, 1536), e, 1024); }
    _Pragma("unroll 1") REP(14) { EpiMergeB e; e.ws = ws; e.m1 = (const bf16_t*)p.out; gm::gemm_phase(lds, dense<8>(ws + O_OLAT + 2048, 1536, ws + O_BTAB + 2048, 1536), e, 512); }
    GBAR;
    _Pragma("unroll 1") REP(15) { EpiWo e; e.x = p.x; e.mod = (const float*)(ws + O_MOD); e.r = (bf16_t*)(ws + O_R16); gm::gemm_phase(lds, dense<8>(ws + O_MIX, 1024, ws + O_BTO, 1024), e, 1024); }
    GBAR; }
    _Pragma("unroll 1") REP(16) ph_ln1(p, lds);
    GBAR;
    {
    _Pragma("unroll 1") REP(10) { EpiRouter e; e.logit = (float*)(ws + O_LOGIT); gm::gemm_phase(lds, dense<1>(ws + O_H2, 2048, ws + O_BTR, 2048), e, 2048); }
    const bool fused_route = gridDim.x == 256;
    if (fused_route && blockIdx.x < 128) { asm volatile("s_waitcnt vmcnt(0)" ::: "memory"); __syncthreads();
        route_block(p, lds, (((int)blockIdx.x & 7) * 16 + ((int)blockIdx.x >> 3)) * 256, 256); __syncthreads(); }
    _Pragma("unroll 1") REP(17) ph_conv_experts(p, lds);
    GBAR; }
    if (gridDim.x != 256) { ph_route(p, lds);
    GBAR; }
    ph_slots(p, lds);
    GBAR;
#pragma unroll 1
    for (int c = 0; c < NCHUNK; ++c) {
        const int ntiles = c < 4 ? ((const int*)(ws + O_TSTART))[c * 128 + 65] : 0;
        if (c < 4) { _Pragma("unroll 1") REP(4) { Exp1Sched s; s.h2 = (const char*)(ws + O_H28); s.btgu = (const char*)(ws + O_BTGU); s.tokof = (const int*)(ws + O_TOKOF) + c * MAXSLOTS; s.tilee = (const int*)(ws + O_TILEE) + c * MAXTILES;
          s.ntiles = ntiles; s.G = gridDim.x; s.c = blockIdx.x; s.lda = 1024; s.ldb = 1024;
          EpiExp1 e; e.hh = ws + O_HH; gm::gemm_phase(lds, s, e, 1024); } }
        if (c < 4) {
        GBAR;
        _Pragma("unroll 1") REP(5) { Exp2Sched s; s.hh = (const char*)(ws + O_HH); s.btd = (const char*)(ws + O_BTD); s.tilee = (const int*)(ws + O_TILEE) + c * MAXTILES;
          s.ntiles = ntiles; s.G = gridDim.x; s.c = blockIdx.x; s.lda = 256; s.ldb = 256;
          EpiExp2 e; e.y = ws + O_Y; e.wd = (const u32x2*)(ws + O_WOF) + c * MAXSLOTS; e.t16 = (const bf16_t*)(ws + O_T16); e.t16o = (bf16_t*)(ws + O_H2); e.mod = (const float*)(ws + O_MOD); gm::gemm_phase(lds, s, e, 256); }
        GBAR;
        _Pragma("unroll 1") REP(18) ph_combine(p, lds, c);
        }
    }
}

extern "C" void kernel_launch(void* const* d_in, const int* in_sizes, int n_in, void* d_out, int out_size, void* d_ws, size_t ws_size, hipStream_t stream) {
    (void)in_sizes; (void)n_in; (void)out_size; (void)ws_size;
    Params p; memset(&p, 0, sizeof(p));
    const float** f = (const float**)&p;
    for (int i = 0; i < 31; ++i) f[i] = (const float*)d_in[i];
    p.out = (float*)d_out; p.ws = (unsigned char*)d_ws;
    for (int i = 0; i < 20; ++i) p.rep[i] = 1;
    p.rep[1] = 0;
    if (PROBE > 0 && PROBE < 20) p.rep[PROBE] = 2;
    if (PROBE == 13) { p.rep[2] = 2; p.rep[13] = 0; }
    static int grid = 0;
    if (!grid) {
        int dev = 0, cus = 0, per_cu = 0;
        (void)hipGetDevice(&dev);
        (void)hipDeviceGetAttribute(&cus, hipDeviceAttributeMultiprocessorCount, dev);
        (void)hipFuncSetAttribute((const void*)mega, hipFuncAttributeMaxDynamicSharedMemorySize, LDS_BYTES);
        (void)hipOccupancyMaxActiveBlocksPerMultiprocessor(&per_cu, mega, 512, LDS_BYTES);
        if (per_cu < 1) per_cu = 1;
        grid = cus * 1;
        if (grid > 256) grid = 256;
    }
    (void)hipMemsetAsync(d_ws, 0, O_ZERO_BYTES, stream);
    hipLaunchKernelGGL(mega, dim3(grid), dim3(512), LDS_BYTES, stream, p);
}
```

```cpp
#include <hip/hip_runtime.h>
#include <stdint.h>
#include <string.h>

#ifndef PROBE
#define PROBE 0
#endif
#define LAS __attribute__((address_space(3)))
typedef unsigned short u16;
typedef unsigned short bf16_t;
typedef short bf16x8 __attribute__((ext_vector_type(8)));
typedef short s16x4 __attribute__((ext_vector_type(4)));
typedef float f32x4 __attribute__((ext_vector_type(4)));
typedef float f32x2 __attribute__((ext_vector_type(2)));
typedef unsigned u32x4 __attribute__((ext_vector_type(4)));
typedef unsigned u32x2 __attribute__((ext_vector_type(2)));
typedef unsigned char LAS* ldsp_t;

constexpr int D = 2048, NB = 4, SEQ = 8192, NT = NB * SEQ;
constexpr int IN_W = 8912, IN_WP = 8960;
constexpr int NEXP = 64, EDIM = 512, NE1 = 65;
constexpr int TOPK = 256;
constexpr float DN_ALPHA = 1.189207115002721f;
constexpr float LN_EPS = 1e-6f;
constexpr int NTHREADS = 512;
constexpr int LDS_BYTES = 160 * 1024;
constexpr int NCHUNK = 2, CHTOK = NT / NCHUNK;
constexpr int MAXTILES = NT * 8 / 256 / NCHUNK + 64 + CHTOK / 256;
constexpr int MAXSLOTS = MAXTILES * 256;
constexpr int HSEG = 8, HSEGL = SEQ / HSEG;

constexpr size_t MB = 1u << 20;
constexpr size_t al(size_t x) { return (x + 255) & ~(size_t)255; }
constexpr size_t O_BAR = 0;
constexpr size_t O_CNT = 16384;
constexpr size_t O_ZERO_BYTES = 16384 + 4096;
constexpr size_t O_MOD = O_ZERO_BYTES;
constexpr size_t O_LB = O_MOD + al((size_t)4 * 12288 * 4);
constexpr size_t O_TSTART = O_LB + 4096;
constexpr size_t O_TILEE = O_TSTART + 2048;
constexpr size_t O_BTR = al(O_TILEE + NCHUNK * MAXTILES * 4 + 4096);
constexpr size_t O_BTIN = O_BTR + (size_t)256 * 2048 * 2;
constexpr size_t O_BTIN8 = O_BTIN + (size_t)768 * 2048 * 2;
constexpr size_t O_BTQ = O_BTIN8 + (size_t)8192 * 2048;
constexpr size_t O_BTAB = O_BTQ + (size_t)3072 * 512 * 2;
constexpr size_t O_BTBB = O_BTAB + (size_t)2048 * 2048 * 2;
constexpr size_t O_BTO = O_BTBB + (size_t)2048 * 1024 * 2;
constexpr size_t O_SMALL_END = O_BTO + (size_t)2048 * 2048 * 2;
constexpr size_t O_B = al(O_SMALL_END);
constexpr size_t O_PSM = O_B;
constexpr size_t O_QB = O_PSM + (size_t)NT * 768 * 2;
constexpr size_t O_LF = O_QB + (size_t)NT * 1024 * 2;
constexpr size_t O_V = O_LF + (size_t)NT * 1024 * 2;
constexpr size_t O_G = O_V + (size_t)NT * 1024 * 2;
constexpr size_t O_SGA = O_G + (size_t)NT * 1024 * 2;
constexpr size_t O_SGB = O_SGA + (size_t)NT * 2048 * 2;
constexpr size_t O_B_END = O_SGB + (size_t)NT * 2048 * 2;
constexpr size_t O_H2 = O_BTIN;
constexpr size_t O_H28 = O_H2 + (size_t)NT * 2048 * 2;
constexpr size_t O_HH = O_H28 + (size_t)NT * 2048;
constexpr size_t O_R16 = O_HH;
constexpr size_t HH_BYTES = (size_t)MAXSLOTS * 512 > (size_t)NT * 2048 * 2 ? (size_t)MAXSLOTS * 512 : (size_t)NT * 2048 * 2;
constexpr size_t O_Y = al(O_HH + HH_BYTES);
constexpr size_t O_LOGIT = O_Y + (size_t)CHTOK * 8 * 2048;
constexpr size_t O_RSEL = O_LOGIT + (size_t)NT * 64 * 4;
constexpr size_t O_RW = O_RSEL + (size_t)NT * 8 * 4;
constexpr size_t O_TOKOF = O_RW + (size_t)NT * 8 * 4;
constexpr size_t O_WOF = O_TOKOF + (size_t)NCHUNK * MAXSLOTS * 4;
constexpr size_t O_DSTOF = O_WOF + (size_t)NCHUNK * MAXSLOTS * 4;
constexpr size_t O_BTGU = al(O_DSTOF + (size_t)NCHUNK * MAXSLOTS * 4);
constexpr size_t O_BTD = O_BTGU + (size_t)NE1 * 1024 * 2048;
constexpr size_t O_END2 = O_BTD + (size_t)NE1 * 2048 * 512;
constexpr size_t O_T16 = al(O_END2);
constexpr size_t O_END3 = O_T16 + (size_t)NT * 2048 * 2;
static_assert(O_END3 <= (size_t)1270 * 1000 * 1000, "workspace budget (MoE time)");
constexpr size_t O_A = al(O_B_END);
constexpr size_t O_HN = O_A;
constexpr size_t O_QLAT = O_A;
constexpr size_t O_MIX = O_A;
constexpr size_t O_C = O_A + (size_t)NT * 2048 * 2;
constexpr size_t O_CQN = O_C;
constexpr size_t O_KV = O_CQN + (size_t)NT * 512 * 2;
constexpr size_t O_KIDX = O_KV + (size_t)NT * 128 * 2;
constexpr size_t O_WIDX = O_KIDX + (size_t)NT * 64 * 2;
constexpr size_t O_QIDX = O_WIDX + (size_t)NT * 16 * 4;
constexpr size_t O_SEL = O_QIDX + (size_t)NT * 1024 * 2;
constexpr size_t O_OLAT = O_SEL + (size_t)NT * 256 * 2;
constexpr size_t O_OB = O_OLAT + (size_t)NT * 2048 * 2;
constexpr size_t O_HST = O_OB + (size_t)NT * 1024 * 2;
constexpr size_t O_HDEC = O_HST + (size_t)256 * 128 * 128 * 4;
constexpr size_t O_END1 = O_HDEC + (size_t)256 * 128 * 4;
constexpr size_t O_H8 = al(O_END1);
constexpr size_t O_END1B = O_H8 + (size_t)NT * 2048;
static_assert(O_END1B <= (size_t)1270 * 1000 * 1000, "workspace budget");

struct Params {
    const float *x, *c, *rpb, *lbl, *ada_w, *ada_b, *w_in, *qng, *kvng, *w_uq, *w_uk, *w_uv, *w_qidx, *ikg, *ikb, *hong,
        *w_ba, *w_bb, *w_o, *ln1g, *ln1b, *w_router, *rbias, *w_eg, *w_eu, *w_ed, *w_sg, *w_su, *w_sd, *ln2g, *ln2b;
    float* out;
    unsigned char* ws;
    int rep[20];
};

__device__ __forceinline__ float bf2f(unsigned short b) { return __uint_as_float(((unsigned)b) << 16); }
__device__ __forceinline__ unsigned short f2bf(float f) { unsigned u = __float_as_uint(f); u += 0x7FFFu + ((u >> 16) & 1u); return (unsigned short)(u >> 16); }
__device__ __forceinline__ unsigned pk_bf16(float lo, float hi) { unsigned r; asm volatile("v_cvt_pk_bf16_f32 %0, %1, %2" : "=v"(r) : "v"(lo), "v"(hi)); return r; }
__device__ __forceinline__ float sigmoidf_(float v) { return __builtin_amdgcn_rcpf(1.0f + __expf(-v)); }
__device__ __forceinline__ float siluf_(float v) { return v * __builtin_amdgcn_rcpf(1.0f + __expf(-v)); }
#define DPPF(v, ctrl) __int_as_float(__builtin_amdgcn_update_dpp(0, __float_as_int(v), ctrl, 0xf, 0xf, false))
__device__ __forceinline__ float wave_sum(float v) {
    v += DPPF(v, 0xB1); v += DPPF(v, 0x4E); v += DPPF(v, 0x141); v += DPPF(v, 0x140);
    u32x2 r = __builtin_amdgcn_permlane16_swap(__float_as_uint(v), __float_as_uint(v), false, false); v = __uint_as_float(r[0]) + __uint_as_float(r[1]);
    r = __builtin_amdgcn_permlane32_swap(__float_as_uint(v), __float_as_uint(v), false, false); v = __uint_as_float(r[0]) + __uint_as_float(r[1]);
    return v;
}
__device__ __forceinline__ int wave_sum_i(int v) {
#pragma unroll
    for (int o = 32; o >= 1; o >>= 1) v += __shfl_xor(v, o);
    return v;
}
__device__ __forceinline__ int opaque_tid() { int t = threadIdx.x; asm volatile("" : "+v"(t)); return t; }
constexpr float OSCALE = 8.0f, MSCALE = 4.0f;
__device__ __forceinline__ unsigned char f2fp8(float v) { return (unsigned char)(__builtin_amdgcn_cvt_pk_fp8_f32(v, v, 0, false) & 0xff); }
constexpr float YSCALE = 16.0f;
__device__ __forceinline__ u32x2 pk8_fp8(const f32x4& v0, const f32x4& v1) {
    int lo = 0, hi = 0;
    lo = __builtin_amdgcn_cvt_pk_fp8_f32(v0[0], v0[1], lo, false); lo = __builtin_amdgcn_cvt_pk_fp8_f32(v0[2], v0[3], lo, true);
    hi = __builtin_amdgcn_cvt_pk_fp8_f32(v1[0], v1[1], hi, false); hi = __builtin_amdgcn_cvt_pk_fp8_f32(v1[2], v1[3], hi, true);
    return (u32x2){(unsigned)lo, (unsigned)hi}; }
#define XB_TMO      128
#define XB_XCNT(j)  (256  + 64 * (j))
#define XB_XSUB(j)  (1280 + 64 * (j))
#define XB_XGEN(j)  (2304 + 64 * (j))
#define XB_TOP      3328
#define XB_TOPGEN   3392
#define XCD_BAR_WORDS 3456
#define XB_SPIN_CAP (1u << 18)

__device__ __forceinline__ unsigned xb_ld(unsigned* p)              { return __hip_atomic_load(p, __ATOMIC_RELAXED, __HIP_MEMORY_SCOPE_AGENT); }
__device__ __forceinline__ unsigned xb_add(unsigned* p, unsigned v) { return __hip_atomic_fetch_add(p, v, __ATOMIC_RELAXED, __HIP_MEMORY_SCOPE_AGENT); }
__device__ __forceinline__ unsigned xb_xcc_id() { return (unsigned)__builtin_amdgcn_s_getreg((3 << 11) | 20) & 0xFu; }
#define XB_SPIN(cond, bar) do { unsigned _sp = 0; while (cond) { __builtin_amdgcn_s_sleep(1); \
    if ((++_sp & 255u) == 0u) { if (xb_ld(&(bar)[XB_TMO])) break; if (_sp > XB_SPIN_CAP) { atomicAdd(&(bar)[XB_TMO], 1u); break; } } } } while (0)

struct XcdBarrier {
    unsigned* bar; unsigned x;
    volatile LAS unsigned* st;
};

__device__ __forceinline__ XcdBarrier xcd_barrier_post(unsigned* bar, volatile LAS unsigned* st) {
    XcdBarrier b; b.bar = bar; b.x = xb_xcc_id(); b.st = st;
    if (threadIdx.x == 0) (void)xb_add(&bar[XB_XCNT(b.x)], 1u);
    return b;
}
__device__ __forceinline__ void xcd_barrier_complete(unsigned* bar, unsigned x, unsigned& nloc, unsigned& nx) {
    const unsigned G = gridDim.x * gridDim.y * gridDim.z;
    unsigned sum, cnt, mine, sp = 0u;
    for (;;) {
        sum = 0u; cnt = 0u; mine = 0u;
#pragma unroll
        for (unsigned j = 0; j < 16; ++j) { const unsigned c = xb_ld(&bar[XB_XCNT(j)]); sum += c; cnt += (c > 0u) ? 1u : 0u; mine = (j == x) ? c : mine; }
        if (sum == G) break;
        __builtin_amdgcn_s_sleep(1);
        if ((++sp & 255u) == 0u) { if (xb_ld(&bar[XB_TMO])) break; if (sp > XB_SPIN_CAP) { atomicAdd(&bar[XB_TMO], 1u); break; } }
    }
    nloc = mine > 0u ? mine : 1u; nx = cnt > 0u ? cnt : 1u;
}

__device__ __forceinline__ void xcd_barrier(const XcdBarrier& b) {
    asm volatile("s_waitcnt vmcnt(0)" ::: "memory");
    __syncthreads();
    if (threadIdx.x == 0) {
        unsigned* bar = b.bar;
        __builtin_amdgcn_s_waitcnt(0);
        unsigned nloc = b.st[0], nx = b.st[1];
        if (nloc == 0u) { xcd_barrier_complete(bar, b.x, nloc, nx); b.st[0] = nloc; b.st[1] = nx; }
        const unsigned old = xb_add(&bar[XB_XSUB(b.x)], 1u);
        const unsigned gen = old / nloc;
        if (old + 1u == (gen + 1u) * nloc) {
            __builtin_amdgcn_fence(__ATOMIC_RELEASE, "agent");
            asm volatile("s_waitcnt vmcnt(0)" ::: "memory");
            const unsigned og = xb_add(&bar[XB_TOP], 1u);
            const unsigned tg = og / nx;
            if (og + 1u == (tg + 1u) * nx) xb_add(&bar[XB_TOPGEN], 1u);
            else XB_SPIN(xb_ld(&bar[XB_TOPGEN]) == tg, bar);
            __builtin_amdgcn_fence(__ATOMIC_ACQUIRE, "agent");
            xb_add(&bar[XB_XGEN(b.x)], 1u);
            asm volatile("s_waitcnt vmcnt(0)" ::: "memory");
        } else {
            XB_SPIN(xb_ld(&bar[XB_XGEN(b.x)]) == gen, bar);
            __builtin_amdgcn_fence(__ATOMIC_ACQUIRE, "agent");
            asm volatile("s_waitcnt vmcnt(0)" ::: "memory");
        }
    }
    __syncthreads();
}
namespace gm {
typedef int i32x4_t __attribute__((ext_vector_type(4)));
typedef int i32x8_t __attribute__((ext_vector_type(8)));
constexpr int BM = 256, BK = 64, HALF = 128, HTB = HALF * BK * 2, STAGE_BYTES = 8 * HTB;
__host__ __device__ __forceinline__ int lds_byte(int r, int c) { const int st = (r >> 4) * 2 + (c >> 5), rr = r & 15, cc = c & 31, ob = rr * 64 + cc * 2; return st * 1024 + (ob ^ (((ob >> 9) & 1) << 5)); }
__host__ __device__ __forceinline__ void stage_rc(int b, int& R, int& C) { const int st = b / 1024, sb = b % 1024, swz = sb ^ (((sb >> 9) & 1) << 5); R = (st >> 1) * 16 + swz / 64; C = (st & 1) * 32 + (swz % 64) / 2; }
__host__ __device__ __forceinline__ int perm32(int rho) { const int n = rho >> 4, i = rho & 15; return 8 * (i >> 2) + 4 * n + (i & 3); }

struct Unit { int pm, pn, e; };

template <class Epi, class Sched>
__device__ __forceinline__ void gemm_phase(ldsp_t lds, const Sched& S, const Epi& E, const int K) {
    const int tid = opaque_tid(), wid = __builtin_amdgcn_readfirstlane(tid >> 6), lane = tid & 63, wr = wid >> 2, wc = wid & 3, fr = lane & 15, fq = lane >> 4;
    const int nt = K / BK;
    int Rr[2], Cc[2];
    unsigned voffB[2], voffA[2][2], nvoffA[2][2];
#pragma unroll
    for (int i = 0; i < 2; ++i) { stage_rc(tid * 16 + i * 8192, Rr[i], Cc[i]); const int Rb = Epi::PERM ? ((Rr[i] & ~31) + perm32(Rr[i] & 31)) : Rr[i];
        voffB[i] = (unsigned)(Rb * S.ldb + Cc[i]) * 2u; }
    const size_t kstep = (size_t)(BK * 2);
    const size_t hstepB = (size_t)HALF * S.ldb * 2;
    const unsigned ldsw = (unsigned)wid * 1024u;
    const int aoff = lds_byte(wr * 64 + fr, fq * 8), boff = lds_byte(wc * 32 + fr, fq * 8);
#define G_SA(b, h) (((b) * 2 + (h)) * HTB)
#define G_SB(b, h) ((4 + (b) * 2 + (h)) * HTB)
#define G_STAGE_B(bufoff, gbase) do { _Pragma("unroll") for (int _i = 0; _i < 2; ++_i) \
        __builtin_amdgcn_global_load_lds((const unsigned*)((const char*)(gbase) + voffB[_i]), (LAS unsigned*)(lds + (bufoff) + ldsw + _i * 8192), 16, 0, 0); } while (0)
#define G_STAGE_A(bufoff, gbase, vo, h) do { _Pragma("unroll") for (int _i = 0; _i < 2; ++_i) \
        __builtin_amdgcn_global_load_lds((const unsigned*)((const char*)(gbase) + (vo)[h][_i]), (LAS unsigned*)(lds + (bufoff) + ldsw + _i * 8192), 16, 0, 0); } while (0)
#define G_LD8(base_) __builtin_shufflevector(*(const LAS i32x4_t*)(base_), *(const LAS i32x4_t*)((base_) + 1024), 0, 1, 2, 3, 4, 5, 6, 7)
#define G_LDA(dst, b, h) do { if constexpr (Epi::FP8) { _Pragma("unroll") for (int m = 0; m < 4; ++m) dst##8[m] = G_LD8(lds + G_SA(b, h) + aoff + m * 2048); } \
        else { _Pragma("unroll") for (int m = 0; m < 4; ++m) _Pragma("unroll") for (int k = 0; k < 2; ++k) dst[m][k] = *(const LAS bf16x8*)(lds + G_SA(b, h) + aoff + m * 2048 + k * 1024); } } while (0)
#define G_LDB(dst, b, h) do { if constexpr (Epi::FP8) { _Pragma("unroll") for (int n = 0; n < 2; ++n) dst##8[n] = G_LD8(lds + G_SB(b, h) + boff + n * 2048); } \
        else { _Pragma("unroll") for (int n = 0; n < 2; ++n) _Pragma("unroll") for (int k = 0; k < 2; ++k) dst[n][k] = *(const LAS bf16x8*)(lds + G_SB(b, h) + boff + n * 2048 + k * 1024); } } while (0)
#define G_MMA(ai, bj, At, Bt) do { __builtin_amdgcn_s_setprio(1); \
        if constexpr (Epi::FP8) { _Pragma("unroll") for (int m = 0; m < 4; ++m) _Pragma("unroll") for (int n = 0; n < 2; ++n) \
            asm volatile("v_mfma_scale_f32_16x16x128_f8f6f4 %0, %1, %2, %0, %3, %3 op_sel_hi:[0,0,0]" : "+v"(acc[ai][bj][m][n]) : "v"(Bt##8[n]), "v"(At##8[m]), "v"(sc_one)); } \
        else { _Pragma("unroll") for (int m = 0; m < 4; ++m) _Pragma("unroll") for (int n = 0; n < 2; ++n) _Pragma("unroll") for (int k = 0; k < 2; ++k) \
            acc[ai][bj][m][n] = __builtin_amdgcn_mfma_f32_16x16x32_bf16(Bt[n][k], At[m][k], acc[ai][bj][m][n], 0, 0, 0); } \
        __builtin_amdgcn_s_setprio(0); } while (0)
#define G_WAIT_V(n) asm volatile("s_waitcnt vmcnt(" #n ")" ::: "memory")
#define G_WAIT_L(n) asm volatile("s_waitcnt lgkmcnt(" #n ")" ::: "memory")
#define G_BAR __builtin_amdgcn_s_barrier()
#define G_SCHED __builtin_amdgcn_sched_barrier(0)
    Unit cur, nxt; int ui = 0;
    if (!S.next(0, cur)) return;
    f32x4 acc[2][2][4][2];
#pragma unroll
    for (int a = 0; a < 2; ++a)
#pragma unroll
        for (int b = 0; b < 2; ++b)
#pragma unroll
            for (int m = 0; m < 4; ++m)
#pragma unroll
                for (int n = 0; n < 2; ++n) acc[a][b][m][n] = (f32x4){0.f, 0.f, 0.f, 0.f};
    const int sc_one = 0x7f7f7f7f; (void)sc_one;
    bf16x8 At[4][2], B0[2][2], B1[2][2]; i32x8_t At8[4], B08[2], B18[2];
    const char* cA = S.a_base(cur); const char* cB = S.b_base(cur);
#pragma unroll
    for (int h = 0; h < 2; ++h)
#pragma unroll
        for (int i = 0; i < 2; ++i) {
            if constexpr (Sched::GATHER) voffA[h][i] = S.a_row_off(cur, h * HALF + Rr[i]) + (unsigned)Cc[i] * 2u;
            else voffA[h][i] = (unsigned)((h * HALF + Rr[i]) * S.lda + Cc[i]) * 2u;
            nvoffA[h][i] = voffA[h][i];
        }
    G_STAGE_B(G_SB(0, 0), cB); G_STAGE_A(G_SA(0, 0), cA, voffA, 0); G_STAGE_B(G_SB(0, 1), cB + hstepB); G_STAGE_A(G_SA(0, 1), cA, voffA, 1);
    if (wr == 1) G_BAR;
    G_WAIT_V(4); G_BAR;
    G_STAGE_B(G_SB(1, 0), cB + kstep); G_STAGE_A(G_SA(1, 0), cA + kstep, voffA, 0); G_STAGE_B(G_SB(1, 1), cB + hstepB + kstep);
    G_WAIT_V(6); G_BAR;
    for (;;) {
        const bool has_next = S.next(ui + 1, nxt);
        const char* nA = has_next ? S.a_base(nxt) : cA; const char* nB = has_next ? S.b_base(nxt) : cB;
        if constexpr (Sched::GATHER) {
            if (has_next) {
#pragma unroll
                for (int h = 0; h < 2; ++h)
#pragma unroll
                    for (int i = 0; i < 2; ++i) nvoffA[h][i] = S.a_row_off(nxt, h * HALF + Rr[i]) + (unsigned)Cc[i] * 2u;
            }
        }
#define G_ACC_FENCE \
        if constexpr (Epi::FP8) { \
            asm volatile("s_nop 15\n\ts_nop 15" : "+v"(acc[0][0][0][0]), "+v"(acc[0][0][0][1]), "+v"(acc[0][0][1][0]), "+v"(acc[0][0][1][1]), "+v"(acc[0][0][2][0]), "+v"(acc[0][0][2][1]), "+v"(acc[0][0][3][0]), "+v"(acc[0][0][3][1]), \
                                                 "+v"(acc[0][1][0][0]), "+v"(acc[0][1][0][1]), "+v"(acc[0][1][1][0]), "+v"(acc[0][1][1][1]), "+v"(acc[0][1][2][0]), "+v"(acc[0][1][2][1]), "+v"(acc[0][1][3][0]), "+v"(acc[0][1][3][1])); \
            asm volatile("" : "+v"(acc[1][0][0][0]), "+v"(acc[1][0][0][1]), "+v"(acc[1][0][1][0]), "+v"(acc[1][0][1][1]), "+v"(acc[1][0][2][0]), "+v"(acc[1][0][2][1]), "+v"(acc[1][0][3][0]), "+v"(acc[1][0][3][1]), \
                             "+v"(acc[1][1][0][0]), "+v"(acc[1][1][0][1]), "+v"(acc[1][1][1][0]), "+v"(acc[1][1][1][1]), "+v"(acc[1][1][2][0]), "+v"(acc[1][1][2][1]), "+v"(acc[1][1][3][0]), "+v"(acc[1][1][3][1])); \
        }
#define G_KLOOP(tb_, te_) \
        for (int t = tb_; t < te_; t += 2) { \
            const bool last = (t == nt - 2); \
            const char* a1 = cA + (size_t)(t + 1) * kstep; \
            const char* a2 = last ? nA : cA + (size_t)(t + 2) * kstep; const char* b2 = last ? nB : cB + (size_t)(t + 2) * kstep; \
            const char* a3 = a2 + kstep; const char* b3 = b2 + kstep; \
            unsigned vo2[2][2]; \
_Pragma("unroll") \
            for (int h = 0; h < 2; ++h) \
_Pragma("unroll") \
                for (int i = 0; i < 2; ++i) vo2[h][i] = (Sched::GATHER && last) ? nvoffA[h][i] : voffA[h][i]; \
            G_LDB(B0, 0, 0); G_SCHED; G_LDA(At, 0, 0); G_STAGE_A(G_SA(1, 1), a1, voffA, 1); \
            G_WAIT_L(8); G_BAR; G_WAIT_L(0); G_MMA(0, 0, At, B0); G_BAR; G_SCHED; \
            G_LDB(B1, 0, 1); G_STAGE_B(G_SB(0, 0), b2); \
            G_BAR; G_WAIT_L(0); G_MMA(0, 1, At, B1); G_BAR; \
            G_LDA(At, 0, 1); G_STAGE_A(G_SA(0, 0), a2, vo2, 0); \
            G_BAR; G_WAIT_L(0); G_MMA(1, 0, At, B0); G_BAR; G_SCHED; \
            G_STAGE_B(G_SB(0, 1), b2 + hstepB); \
            G_WAIT_V(6); G_BAR; G_MMA(1, 1, At, B1); G_BAR; \
            G_LDB(B0, 1, 0); G_SCHED; G_LDA(At, 1, 0); G_STAGE_A(G_SA(0, 1), a2, vo2, 1); \
            G_WAIT_L(8); G_BAR; G_WAIT_L(0); G_MMA(0, 0, At, B0); G_BAR; G_SCHED; \
            G_LDB(B1, 1, 1); G_STAGE_B(G_SB(1, 0), b3); \
            G_BAR; G_WAIT_L(0); G_MMA(0, 1, At, B1); G_BAR; \
            G_LDA(At, 1, 1); G_STAGE_A(G_SA(1, 0), a3, vo2, 0); \
            G_BAR; G_WAIT_L(0); G_MMA(1, 0, At, B0); G_BAR; G_SCHED; \
            G_STAGE_B(G_SB(1, 1), b3 + hstepB); \
            G_WAIT_V(6); G_BAR; G_MMA(1, 1, At, B1); G_BAR; \
        }
        if constexpr (Epi::MID_T >= 0) { G_KLOOP(0, Epi::MID_T) G_ACC_FENCE E.mid(acc, cur, wr, wc, fr, fq); G_KLOOP(Epi::MID_T, nt) }
        else { G_KLOOP(0, nt) }
#undef G_KLOOP
        G_ACC_FENCE
        E(acc, cur, wr, wc, fr, fq);
        if (!has_next) break;
#pragma unroll
        for (int a = 0; a < 2; ++a)
#pragma unroll
            for (int b = 0; b < 2; ++b)
#pragma unroll
                for (int m = 0; m < 4; ++m)
#pragma unroll
                    for (int n = 0; n < 2; ++n) acc[a][b][m][n] = (f32x4){0.f, 0.f, 0.f, 0.f};
        cur = nxt; cA = nA; cB = nB; ++ui;
        if constexpr (Sched::GATHER) {
#pragma unroll
            for (int h = 0; h < 2; ++h)
#pragma unroll
                for (int i = 0; i < 2; ++i) voffA[h][i] = nvoffA[h][i];
        }
    }
    G_WAIT_V(0);
    if (wr == 0) G_BAR;
    G_BAR;
#undef G_SA
#undef G_SB
#undef G_STAGE_A
#undef G_STAGE_B
#undef G_ACC_FENCE
#undef G_LD8
#undef G_LDA
#undef G_LDB
#undef G_MMA
#undef G_WAIT_V
#undef G_WAIT_L
#undef G_BAR
#undef G_SCHED
}

template <int NN>
struct DenseSchedT {
    static constexpr bool GATHER = false;
    const char* A; const char* Bt; int lda, ldb, G, c;
    __device__ __forceinline__ bool next(int i, Unit& u) const {
        constexpr int nwg = 128 * NN, q = nwg / 8, nig = 8 * NN;
        const int L = i * G + c; if (L >= nwg) return false;
        const int wgid = (L & 7) * q + (L >> 3);
        const int gid = wgid / nig, rem = wgid - gid * nig;
        u.pm = gid * 8 + (rem & 7); u.pn = rem >> 3; u.e = 0; return true;
    }
    __device__ __forceinline__ const char* a_base(const Unit& u) const { return A + (size_t)u.pm * 256 * lda * 2; }
    __device__ __forceinline__ unsigned a_row_off(const Unit&, int) const { return 0u; }
    __device__ __forceinline__ const char* b_base(const Unit& u) const { return Bt + (size_t)u.pn * 256 * ldb * 2; }
};
}
__device__ __forceinline__ int conv_row(int n, int mode) {
    if (mode == 0) return n;
    if (mode == 1) return n < 720 ? n : n + 48;
    return (n >> 7) * 256 + (n & 127) + (mode == 3 ? 128 : 0);
}
__device__ __forceinline__ void conv_job(ldsp_t lds, const float* src, int ld_src, int K, int N, bf16_t* dst, int ld_dst, int mode, int nbatch, size_t sb, size_t db) {
    LAS float* tile = (LAS float*)lds;
    const int tid = opaque_tid(), tk = K / 128, tn = (N + 127) / 128, per = tk * tn, total = per * nbatch;
    for (int t = blockIdx.x; t < total; t += gridDim.x) {
        const int bi = t / per, tt = t % per, k0 = (tt / tn) * 128, n0 = (tt % tn) * 128;
        const float* s = src + (size_t)bi * sb; bf16_t* d = dst + (size_t)bi * db;
        const int r = tid >> 5, c4 = (tid & 31) * 4;
        f32x4 v[8];
#pragma unroll
        for (int ps = 0; ps < 8; ++ps) { v[ps] = (f32x4){0.f, 0.f, 0.f, 0.f}; if (n0 + c4 < N) v[ps] = *(const f32x4*)(s + (size_t)(k0 + r + 16 * ps) * ld_src + n0 + c4); }
        __syncthreads();
#pragma unroll
        for (int ps = 0; ps < 8; ++ps) { const int k = r + 16 * ps; tile[k * 129 + c4 + 0] = v[ps][0]; tile[k * 129 + c4 + 1] = v[ps][1]; tile[k * 129 + c4 + 2] = v[ps][2]; tile[k * 129 + c4 + 3] = v[ps][3]; }
        __syncthreads();
        const int nn = tid >> 2, kq = tid & 3;
        if (n0 + nn < N) {
            bf16_t* drow = d + (size_t)conv_row(n0 + nn, mode) * ld_dst + k0;
#pragma unroll
            for (int ps = 0; ps < 4; ++ps) {
                const int k8 = (kq + 4 * ps) * 8;
                float f[8];
#pragma unroll
                for (int j = 0; j < 8; ++j) f[j] = tile[(k8 + j) * 129 + nn];
                u32x4 w; w.x = pk_bf16(f[0], f[1]); w.y = pk_bf16(f[2], f[3]); w.z = pk_bf16(f[4], f[5]); w.w = pk_bf16(f[6], f[7]);
                *(u32x4*)(drow + k8) = w;
            }
        }
    }
    __syncthreads();
}
__device__ __forceinline__ void conv_job8(ldsp_t lds, const float* src, int ld_src, int K, int N, unsigned char* dst, int ld_dst, int mode, int nbatch, size_t sb, size_t db, bool kperm = false) {
    const int tid = opaque_tid(), wv = __builtin_amdgcn_readfirstlane(tid >> 6), lane = tid & 63;
    const int tk = K / 128, tn = N / 128, per = tk * tn, total = per * nbatch, G = gridDim.x;
    const int hl = lane >> 5, slot = lane & 31;
    const int kb = tid & 15, nblk = tid >> 4;
    auto issue = [&](int t, int buf) {
        const int bi = t / per, tt = t % per, k0 = (tt / tn) * 128, n0 = (tt % tn) * 128;
        const float* s = src + (size_t)bi * sb + (size_t)k0 * ld_src + n0;
#pragma unroll
        for (int i = 0; i < 8; ++i) { const int row = (wv * 8 + i) * 2 + hl, piece = slot ^ ((row >> 3) & 15);
            __builtin_amdgcn_global_load_lds((const unsigned*)(s + (size_t)row * ld_src + piece * 4), (LAS unsigned*)(lds + buf * 65536 + (wv * 8 + i) * 1024), 16, 0, 0); }
    };
    int t = blockIdx.x, buf = 0;
    __syncthreads();
    if (t < total) issue(t, 0);
#pragma unroll 1
    for (; t < total; t += G, buf ^= 1) {
        if (t + G < total) { issue(t + G, buf ^ 1); asm volatile("s_waitcnt vmcnt(8)" ::: "memory"); } else asm volatile("s_waitcnt vmcnt(0)" ::: "memory");
        __syncthreads();
        const int bi = t / per, tt = t % per, k0 = (tt / tn) * 128, n0 = (tt % tn) * 128;
        f32x4 f[8];
#pragma unroll
        for (int j = 0; j < 8; ++j) f[j] = *(LAS const f32x4*)(lds + buf * 65536 + (kb * 8 + j) * 512 + ((nblk ^ kb) * 16));
        const int k8 = k0 + kb * 8;
        unsigned char* d = dst + (size_t)bi * db + (kperm ? (k8 & ~255) + ((k8 >> 5) & 3) * 64 + ((k8 >> 3) & 3) * 16 + ((k8 >> 7) & 1) * 8 : k8);
#pragma unroll
        for (int c = 0; c < 4; ++c) {
            const u32x2 w = pk8_fp8((f32x4){f[0][c], f[1][c], f[2][c], f[3][c]} * 64.0f, (f32x4){f[4][c], f[5][c], f[6][c], f[7][c]} * 64.0f);
            *(u32x2*)(d + (size_t)conv_row(n0 + nblk * 4 + c, mode) * ld_dst) = w;
        }
        __syncthreads();
    }
}
__device__ __forceinline__ void zero_fill16(unsigned char* dst, size_t bytes) {
    const size_t n = bytes / 16;
    for (size_t i = (size_t)blockIdx.x * NTHREADS + opaque_tid(); i < n; i += (size_t)gridDim.x * NTHREADS) ((u32x4*)dst)[i] = (u32x4){0u, 0u, 0u, 0u};
}

__device__ __forceinline__ void ph_conv_small(const Params& p, ldsp_t lds) {
    unsigned char* ws = p.ws;
    bf16_t* btin = (bf16_t*)(ws + O_BTIN); bf16_t* btq = (bf16_t*)(ws + O_BTQ); bf16_t* btab = (bf16_t*)(ws + O_BTAB);
    bf16_t* btbb = (bf16_t*)(ws + O_BTBB); bf16_t* bto = (bf16_t*)(ws + O_BTO); bf16_t* btr = (bf16_t*)(ws + O_BTR);
    const int tid = opaque_tid();
    conv_job(lds, p.w_in, IN_W, 2048, 720, btin, 2048, 0, 1, 0, 0);
    conv_job8(lds, p.w_in + 720, IN_W, 2048, 8192, ws + O_BTIN8, 2048, 0, 1, 0, 0);
    conv_job(lds, p.w_qidx, 1024, 512, 1024, btq + (size_t)2048 * 512, 512, 0, 1, 0, 0);
    conv_job8(lds, p.w_bb, 2048, 1024, 2048, (unsigned char*)btab + 2048, 3072, 0, 1, 0, 0);
    conv_job8(lds, p.w_o, 2048, 2048, 2048, (unsigned char*)bto, 2048, 0, 1, 0, 0, true);
    conv_job(lds, p.w_router, 64, 2048, 64, btr, 2048, 0, 1, 0, 0);
    zero_fill16((unsigned char*)(btin + (size_t)720 * 2048), (size_t)48 * 2048 * 2);
    zero_fill16((unsigned char*)(btr + (size_t)64 * 2048), (size_t)192 * 2048 * 2);
    if (blockIdx.x == 0) for (int i = tid; i < 1024; i += NTHREADS) { const float a = p.lbl[i], b = p.lbl[1024 + i]; ((float*)(ws + O_LB))[i] = 1.0f / (1.0f + __expf(b - a)); }
    for (int u = blockIdx.x; u < 256; u += gridDim.x) {
        const int n0 = u * 8, h = n0 >> 7, c0 = n0 & 127, r = tid;
        float sacc[8];
#pragma unroll
        for (int ci = 0; ci < 8; ++ci) sacc[ci] = 0.f;
#pragma unroll 2
        for (int d4 = 0; d4 < 32; ++d4) {
            const f32x4 v = *(const f32x4*)(p.w_uq + (size_t)r * 2048 + h * 128 + d4 * 4);
#pragma unroll
            for (int ci = 0; ci < 8; ++ci) { const f32x4 k4 = *(const f32x4*)(p.w_uk + ((size_t)h * 128 + c0 + ci) * 128 + d4 * 4);
                sacc[ci] += (v[0] * k4[0] + v[1] * k4[1]) + (v[2] * k4[2] + v[3] * k4[3]); }
        }
#pragma unroll
        for (int ci = 0; ci < 8; ++ci) btq[(size_t)(n0 + ci) * 512 + r] = f2bf(sacc[ci]);
    }
    for (int u = blockIdx.x; u < 256; u += gridDim.x) {
        const int h = u >> 4, nb = u & 15;
        LAS float* tb = (LAS float*)lds;
        __syncthreads();
        for (int i = tid; i < 64 * 32; i += NTHREADS) { const int v = i >> 5, n4 = (i & 31) * 4; const f32x4 x = *(const f32x4*)(p.w_ba + (size_t)(h * 64 + v) * 2048 + nb * 128 + n4);
            tb[v * 128 + n4] = x[0]; tb[v * 128 + n4 + 1] = x[1]; tb[v * 128 + n4 + 2] = x[2]; tb[v * 128 + n4 + 3] = x[3]; }
        __syncthreads();
        const int c = tid & 127, nq = tid >> 7;
        float aacc[32];
#pragma unroll
        for (int i = 0; i < 32; ++i) aacc[i] = 0.f;
#pragma unroll 1
        for (int v = 0; v < 64; ++v) {
            const float uvv = p.w_uv[((size_t)h * 128 + c) * 64 + v];
#pragma unroll
            for (int i4 = 0; i4 < 8; ++i4) { const f32x4 t4 = *(const LAS f32x4*)(tb + v * 128 + nq * 32 + i4 * 4);
                aacc[i4 * 4] += uvv * t4[0]; aacc[i4 * 4 + 1] += uvv * t4[1]; aacc[i4 * 4 + 2] += uvv * t4[2]; aacc[i4 * 4 + 3] += uvv * t4[3]; }
        }
        const int cp = ((c >> 2) & 3) * 32 + (c >> 4) * 4 + (c & 3);
#pragma unroll
        for (int i = 0; i < 32; ++i) ((unsigned char*)btab)[(size_t)(nb * 128 + nq * 32 + i) * 3072 + h * 128 + cp] = f2fp8(aacc[i] * 64.0f);
    }
    __syncthreads();
}

__device__ __forceinline__ void ph_conv_experts(const Params& p, ldsp_t lds) {
    unsigned char* btgu = p.ws + O_BTGU; unsigned char* btd = p.ws + O_BTD;
    conv_job8(lds, p.w_eg, 512, 2048, 512, btgu, 2048, 2, 64, (size_t)2048 * 512, (size_t)1024 * 2048);
    conv_job8(lds, p.w_eu, 512, 2048, 512, btgu, 2048, 3, 64, (size_t)2048 * 512, (size_t)1024 * 2048);
    conv_job8(lds, p.w_ed, 2048, 512, 2048, btd, 512, 0, 64, (size_t)512 * 2048, (size_t)2048 * 512);
    conv_job8(lds, p.w_sg, 512, 2048, 512, btgu + (size_t)64 * 1024 * 2048, 2048, 2, 1, 0, 0);
    conv_job8(lds, p.w_su, 512, 2048, 512, btgu + (size_t)64 * 1024 * 2048, 2048, 3, 1, 0, 0);
    conv_job8(lds, p.w_sd, 2048, 512, 2048, btd + (size_t)64 * 2048 * 512, 512, 0, 1, 0, 0);
}

__device__ __forceinline__ void ph_mod(const Params& p, ldsp_t lds) {
    LAS float* cond = (LAS float*)lds;
    LAS float* red = (LAS float*)(lds + 32768);
    float* mod = (float*)(p.ws + O_MOD);
    const int tid = opaque_tid();
    for (int w = blockIdx.x; w < 256; w += gridDim.x) {
        __syncthreads();
        for (int i = tid; i < 4 * 2048; i += NTHREADS) cond[i] = siluf_(p.c[i]);
        __syncthreads();
        if (tid < 384) {
            const int cq = tid % 12, kl = tid / 12;
            float a[4][4];
#pragma unroll
            for (int b = 0; b < 4; ++b)
#pragma unroll
                for (int j = 0; j < 4; ++j) a[b][j] = 0.f;
#pragma unroll 1
            for (int k0 = kl; k0 < 2048; k0 += 256) {
                f32x4 wv[8];
#pragma unroll
                for (int u8 = 0; u8 < 8; ++u8) wv[u8] = *(const f32x4*)(p.ada_w + (size_t)(k0 + 32 * u8) * 12288 + w * 48 + cq * 4);
#pragma unroll
                for (int u8 = 0; u8 < 8; ++u8) { const int k = k0 + 32 * u8;
#pragma unroll
                    for (int b = 0; b < 4; ++b) { const float cb = cond[b * 2048 + k];
#pragma unroll
                        for (int j = 0; j < 4; ++j) a[b][j] += cb * wv[u8][j]; } }
            }
#pragma unroll
            for (int b = 0; b < 4; ++b)
#pragma unroll
                for (int j = 0; j < 4; ++j) red[(kl * 12 + cq) * 16 + b * 4 + j] = a[b][j];
        }
        __syncthreads();
        if (tid < 192) {
            const int cq = tid / 16, bj = tid % 16, b = bj >> 2, j = bj & 3;
            float s = 0.f;
            for (int kl = 0; kl < 32; ++kl) s += red[(kl * 12 + cq) * 16 + bj];
            const int n = w * 48 + cq * 4 + j;
            mod[b * 12288 + n] = s + p.ada_b[n];
        }
    }
    __syncthreads();
}

__device__ __forceinline__ void ph_lnmod(const Params& p, ldsp_t lds) {
    const float* mod = (const float*)(p.ws + O_MOD);
    bf16_t* hn = (bf16_t*)(p.ws + O_HN); unsigned char* h8 = p.ws + O_H8;
    const int tid_ = opaque_tid(); const int lane = tid_ & 63, wv = tid_ >> 6;
    const bool bmap = gridDim.x == 256;
    const int row0 = bmap ? ((int)(blockIdx.x & 3) * SEQ + (int)(blockIdx.x >> 2) * 8 + wv) : (int)blockIdx.x * 8 + wv;
    const int rstride = bmap ? 512 : (int)gridDim.x * 8, rend = bmap ? ((int)(blockIdx.x & 3) + 1) * SEQ : NT;
    LAS float* psh = (LAS float*)lds;
    __syncthreads();
    if (bmap) { const int b = blockIdx.x & 3; for (int i = tid_; i < 2048; i += NTHREADS) { psh[i] = mod[b * 12288 + i]; psh[2048 + i] = mod[b * 12288 + 2048 + i] + 1.0f; } }
    else { for (int i = tid_; i < 4 * 2048; i += NTHREADS) { const int b = i >> 11, c = i & 2047; psh[b * 4096 + c] = mod[b * 12288 + c]; psh[b * 4096 + 2048 + c] = mod[b * 12288 + 2048 + c] + 1.0f; } }
    __syncthreads();
#pragma unroll 1
    for (int row = row0; row < rend; row += rstride) {
        const LAS float* sh = bmap ? psh : psh + (row >> 13) * 4096;
        const float* xr = p.x + (size_t)row * 2048;
        f32x4 v[8]; float s = 0.f;
#pragma unroll
        for (int i = 0; i < 8; ++i) { v[i] = *(const f32x4*)(xr + (i * 64 + lane) * 4); s += (v[i][0] + v[i][1]) + (v[i][2] + v[i][3]); }
        const float mu = wave_sum(s) * (1.0f / 2048.0f);
        float q = 0.f;
#pragma unroll
        for (int i = 0; i < 8; ++i) { v[i] -= mu; q += (v[i][0] * v[i][0] + v[i][1] * v[i][1]) + (v[i][2] * v[i][2] + v[i][3] * v[i][3]); }
        const float rstd = rsqrtf(wave_sum(q) * (1.0f / 2048.0f) + LN_EPS);
#pragma unroll
        for (int i = 0; i < 8; ++i) {
            const int col = (i * 64 + lane) * 4;
            const f32x4 y = v[i] * rstd * *(const LAS f32x4*)(sh + 2048 + col) + *(const LAS f32x4*)(sh + col);
            u32x2 w; w.x = pk_bf16(y[0], y[1]); w.y = pk_bf16(y[2], y[3]);
            *(u32x2*)(hn + (size_t)row * 2048 + col) = w;
            { int q8 = 0; q8 = __builtin_amdgcn_cvt_pk_fp8_f32(y[0], y[1], q8, false); q8 = __builtin_amdgcn_cvt_pk_fp8_f32(y[2], y[3], q8, true); *(int*)(h8 + (size_t)row * 2048 + col) = q8; }
        }
    }
    __syncthreads();
}
using gm::Unit;
__device__ __forceinline__ unsigned pk_f16(float lo, float hi) { const _Float16 a = (_Float16)lo, b = (_Float16)hi; return (unsigned)__builtin_bit_cast(unsigned short, a) | ((unsigned)__builtin_bit_cast(unsigned short, b) << 16); }
__device__ __forceinline__ void st8_bf16(bf16_t* dst, const f32x4& v0, const f32x4& v1) {
    u32x4 w; w.x = pk_bf16(v0[0], v0[1]); w.y = pk_bf16(v0[2], v0[3]); w.z = pk_bf16(v1[0], v1[1]); w.w = pk_bf16(v1[2], v1[3]); *(u32x4*)dst = w; }

template <bool F8>
struct EpiInProj {
    static constexpr bool PERM = true; static constexpr int MID_T = -1; static constexpr bool FP8 = F8;
    unsigned char* ws;
    __device__ __forceinline__ void operator()(const f32x4 (&acc)[2][2][4][2], const Unit& u, int wr, int wc, int fr, int fq) const {
        const int pn = u.pn + (F8 ? 3 : 0); const int row0 = u.pm * 256 + wr * 64 + fr;
        const float* lb = (const float*)(ws + O_LB);
        int type, cbase, ldo; bf16_t* base;
        if (pn < 3) { type = 0; base = (bf16_t*)(ws + O_PSM); cbase = pn * 256; ldo = 768; }
        else if (pn < 7) { type = 1; base = (bf16_t*)(ws + O_QB); cbase = (pn - 3) * 256; ldo = 1024; }
        else if (pn < 11) { type = 2; base = (bf16_t*)(ws + O_LF); cbase = (pn - 7) * 256; ldo = 1024; }
        else if (pn < 15) { type = 0; base = (bf16_t*)(ws + O_V); cbase = (pn - 11) * 256; ldo = 1024; }
        else if (pn < 19) { type = 3; base = (bf16_t*)(ws + O_G); cbase = (pn - 15) * 256; ldo = 1024; }
        else if (pn < 27) { type = 4; base = (bf16_t*)(ws + O_SGA); cbase = (pn - 19) * 256; ldo = 2048; }
        else { type = 4; base = (bf16_t*)(ws + O_SGB); cbase = (pn - 27) * 256; ldo = 2048; }
        if (type == 4) {
#pragma unroll
            for (int ai = 0; ai < 2; ++ai)
#pragma unroll
                for (int m = 0; m < 4; ++m) {
                    const int row = row0 + ai * 128 + m * 16;
                    unsigned w[4] = {0u, 0u, 0u, 0u};
#pragma unroll
                    for (int bj = 0; bj < 2; ++bj)
#pragma unroll
                        for (int j = 0; j < 4; ++j) { w[2 * bj] |= (unsigned)(sigmoidf_(acc[ai][bj][m][0][j] * (1.0f / 64.0f)) * 255.0f + 0.5f) << (8 * j); w[2 * bj + 1] |= (unsigned)(sigmoidf_(acc[ai][bj][m][1][j] * (1.0f / 64.0f)) * 255.0f + 0.5f) << (8 * j); }
                    *(u32x4*)((unsigned char*)base + (size_t)row * 2048 + cbase + wc * 64 + fq * 16) = (u32x4){w[0], w[1], w[2], w[3]};
                }
            return;
        }
#pragma unroll
        for (int bj = 0; bj < 2; ++bj) {
            const int col = cbase + bj * 128 + wc * 32 + 8 * fq;
            f32x4 l0 = (f32x4){0.f, 0.f, 0.f, 0.f}, l1 = l0;
            if (type == 2) { l0 = *(const f32x4*)(lb + col); l1 = *(const f32x4*)(lb + col + 4); }
#pragma unroll
            for (int ai = 0; ai < 2; ++ai)
#pragma unroll
                for (int m = 0; m < 4; ++m) {
                    const int row = row0 + ai * 128 + m * 16;
                    f32x4 v0 = acc[ai][bj][m][0], v1 = acc[ai][bj][m][1];
                    if (F8) { v0 *= (1.0f / 64.0f); v1 *= (1.0f / 64.0f); }
                    bf16_t* dst = base + (size_t)row * ldo + col;
                    if (type == 2) {
                        float f[8];
#pragma unroll
                        for (int j = 0; j < 4; ++j) { f[j] = __logf(l0[j] + (1.0f - l0[j]) * sigmoidf_(v0[j])); f[4 + j] = __logf(l1[j] + (1.0f - l1[j]) * sigmoidf_(v1[j])); }
                        u32x4 w; w.x = pk_f16(f[0], f[1]); w.y = pk_f16(f[2], f[3]); w.z = pk_f16(f[4], f[5]); w.w = pk_f16(f[6], f[7]);
                        *(u32x4*)dst = w;
                    } else {
                        if (type == 1) {
#pragma unroll
                            for (int j = 0; j < 4; ++j) { v0[j] = siluf_(v0[j]) * 0.08838834764831845f; v1[j] = siluf_(v1[j]) * 0.08838834764831845f; }
                        } else if (type == 3) {
#pragma unroll
                            for (int j = 0; j < 4; ++j) { v0[j] = siluf_(v0[j]); v1[j] = siluf_(v1[j]); }
                        }
                        st8_bf16(dst, v0, v1);
                    }
                }
        }
    }
};
struct EpiQ {
    static constexpr bool PERM = true; static constexpr int MID_T = -1; static constexpr bool FP8 = false;
    unsigned char* ws;
    __device__ __forceinline__ void operator()(const f32x4 (&acc)[2][2][4][2], const Unit& u, int wr, int wc, int fr, int fq) const {
        const int pn = u.pn; const int row0 = u.pm * 256 + wr * 64 + fr;
        const bool lat = pn < 8;
        bf16_t* base = (bf16_t*)(ws + (lat ? O_QLAT : O_QIDX)); const int ldo = lat ? 2048 : 1024, cbase = (lat ? pn : pn - 8) * 256; const float sc = lat ? 0.08838834764831845f : 1.0f;
#pragma unroll
        for (int ai = 0; ai < 2; ++ai)
#pragma unroll
            for (int m = 0; m < 4; ++m)
#pragma unroll
                for (int bj = 0; bj < 2; ++bj) {
                    const int row = row0 + ai * 128 + m * 16, col = cbase + bj * 128 + wc * 32 + 8 * fq;
                    st8_bf16(base + (size_t)row * ldo + col, acc[ai][bj][m][0] * sc, acc[ai][bj][m][1] * sc);
                }
    }
};
__device__ __forceinline__ void unpack8(const u32x4& g, float (&f)[8]) {
    f[0] = __uint_as_float(g.x << 16); f[1] = __uint_as_float(g.x & 0xffff0000u); f[2] = __uint_as_float(g.y << 16); f[3] = __uint_as_float(g.y & 0xffff0000u);
    f[4] = __uint_as_float(g.z << 16); f[5] = __uint_as_float(g.z & 0xffff0000u); f[6] = __uint_as_float(g.w << 16); f[7] = __uint_as_float(g.w & 0xffff0000u); }
__device__ __forceinline__ void unpack8u(const u32x2& g, float (&f)[8]) {
    f[0] = (float)((g.x >> 0) & 0xffu); f[1] = (float)((g.x >> 8) & 0xffu); f[2] = (float)((g.x >> 16) & 0xffu); f[3] = (float)((g.x >> 24) & 0xffu);
    f[4] = (float)((g.y >> 0) & 0xffu); f[5] = (float)((g.y >> 8) & 0xffu); f[6] = (float)((g.y >> 16) & 0xffu); f[7] = (float)((g.y >> 24) & 0xffu); }
struct EpiMergeA {
    static constexpr bool PERM = true; static constexpr int MID_T = -1; static constexpr bool FP8 = true;
    unsigned char* ws; bf16_t* m1;
    __device__ __forceinline__ void operator()(const f32x4 (&acc)[2][2][4][2], const Unit& u, int wr, int wc, int fr, int fq) const {
        const int row0 = u.pm * 256 + wr * 64 + fr; const unsigned char* __restrict__ sg = ws + O_SGA;
        const int colb = u.pn * 256 + wc * 32 + 8 * fq;
#pragma unroll
        for (int ai = 0; ai < 2; ++ai) {
            u32x2 g[4][2];
#pragma unroll
            for (int m = 0; m < 4; ++m) { const u32x4 gq = *(const u32x4*)(sg + (size_t)(row0 + ai * 128 + m * 16) * 2048 + u.pn * 256 + wc * 64 + fq * 16);
                g[m][0] = (u32x2){gq.x, gq.y}; g[m][1] = (u32x2){gq.z, gq.w}; }
#pragma unroll
            for (int m = 0; m < 4; ++m)
#pragma unroll
                for (int bj = 0; bj < 2; ++bj) {
                    float f[8]; unpack8u(g[m][bj], f);
                    f32x4 o0, o1;
#pragma unroll
                    for (int j = 0; j < 4; ++j) { o0[j] = f[j] * acc[ai][bj][m][0][j] * (1.0f / (255.0f * 64.0f * OSCALE)); o1[j] = f[4 + j] * acc[ai][bj][m][1][j] * (1.0f / (255.0f * 64.0f * OSCALE)); }
                    st8_bf16(m1 + (size_t)(row0 + ai * 128 + m * 16) * 2048 + colb + bj * 128, o0, o1);
                }
        }
    }
};
struct EpiMergeB {
    static constexpr bool PERM = true; static constexpr int MID_T = -1; static constexpr bool FP8 = true;
    unsigned char* ws; const bf16_t* m1;
    __device__ __forceinline__ void operator()(const f32x4 (&acc)[2][2][4][2], const Unit& u, int wr, int wc, int fr, int fq) const {
        const int row0 = u.pm * 256 + wr * 64 + fr; const unsigned char* __restrict__ sg = ws + O_SGB; unsigned char* mix = ws + O_MIX;
        const int colb = u.pn * 256 + wc * 32 + 8 * fq, pos = u.pn * 256 + wc * 64 + fq * 16;
#pragma unroll
        for (int ai = 0; ai < 2; ++ai)
#pragma unroll
            for (int mh = 0; mh < 2; ++mh) {
                u32x4 g[2], a[2][2];
#pragma unroll
                for (int mm = 0; mm < 2; ++mm) { const size_t ro = (size_t)(row0 + ai * 128 + (2 * mh + mm) * 16) * 2048; g[mm] = *(const u32x4*)(sg + ro + pos);
                    a[mm][0] = *(const u32x4*)(m1 + ro + colb); a[mm][1] = *(const u32x4*)(m1 + ro + colb + 128); }
#pragma unroll
                for (int mm = 0; mm < 2; ++mm) { const int m = 2 * mh + mm;
                    u32x2 w8[2];
#pragma unroll
                    for (int bj = 0; bj < 2; ++bj) {
                        float f[8], pa[8]; unpack8u(bj ? (u32x2){g[mm].z, g[mm].w} : (u32x2){g[mm].x, g[mm].y}, f); unpack8(a[mm][bj], pa);
                        f32x4 o0, o1;
#pragma unroll
                        for (int j = 0; j < 4; ++j) { o0[j] = (pa[j] + f[j] * acc[ai][bj][m][0][j] * (1.0f / (255.0f * 64.0f * OSCALE))) * MSCALE; o1[j] = (pa[4 + j] + f[4 + j] * acc[ai][bj][m][1][j] * (1.0f / (255.0f * 64.0f * OSCALE))) * MSCALE; }
                        w8[bj] = pk8_fp8(o0, o1);
                    }
                    *(u32x4*)(mix + (size_t)(row0 + ai * 128 + m * 16) * 2048 + pos) = (u32x4){w8[0].x, w8[0].y, w8[1].x, w8[1].y};
                }
            }
    }
};
struct EpiWo {
    static constexpr bool PERM = true; static constexpr int MID_T = -1; static constexpr bool FP8 = true;
    const float* x; const float* mod; bf16_t* r;
    __device__ __forceinline__ void operator()(const f32x4 (&acc)[2][2][4][2], const Unit& u, int wr, int wc, int fr, int fq) const {
        const int row0 = u.pm * 256 + wr * 64 + fr; const int b = (u.pm * 256) >> 13;
        const float* __restrict__ xx = x;
#pragma unroll
        for (int bj = 0; bj < 2; ++bj) {
            const int col = u.pn * 256 + bj * 128 + wc * 32 + 8 * fq;
            const f32x4 g0 = *(const f32x4*)(mod + b * 12288 + 2 * 2048 + col), g1 = *(const f32x4*)(mod + b * 12288 + 2 * 2048 + col + 4);
#pragma unroll
            for (int ai = 0; ai < 2; ++ai) {
                f32x4 x0[4], x1[4];
#pragma unroll
                for (int m = 0; m < 4; ++m) { const float* xr = xx + (size_t)(row0 + ai * 128 + m * 16) * 2048 + col; x0[m] = *(const f32x4*)xr; x1[m] = *(const f32x4*)(xr + 4); }
#pragma unroll
                for (int m = 0; m < 4; ++m) st8_bf16(r + (size_t)(row0 + ai * 128 + m * 16) * 2048 + col, x0[m] * DN_ALPHA + g0 * (acc[ai][bj][m][0] * (1.0f / (64.0f * MSCALE))), x1[m] * DN_ALPHA + g1 * (acc[ai][bj][m][1] * (1.0f / (64.0f * MSCALE))));
            }
        }
    }
};
struct EpiRouter {
    static constexpr bool PERM = false; static constexpr int MID_T = -1; static constexpr bool FP8 = false;
    float* logit;
    __device__ __forceinline__ void operator()(const f32x4 (&acc)[2][2][4][2], const Unit& u, int wr, int wc, int fr, int fq) const {
        const int row0 = u.pm * 256 + wr * 64 + fr;
        if (wc < 2) {
#pragma unroll
            for (int n = 0; n < 2; ++n)
#pragma unroll
                for (int ai = 0; ai < 2; ++ai)
#pragma unroll
                    for (int m = 0; m < 4; ++m) {
                        const int row = row0 + ai * 128 + m * 16, col = wc * 32 + n * 16 + 4 * fq;
                        *(f32x4*)(logit + (size_t)row * 64 + col) = acc[ai][0][m][n];
                    }
        }
    }
};
constexpr float WSCALE = 64.0f, HSCALE = 4.0f;
struct EpiExp1 {
    static constexpr bool PERM = true; static constexpr int MID_T = -1; static constexpr bool FP8 = true;
    unsigned char* hh;
    __device__ __forceinline__ void operator()(const f32x4 (&acc)[2][2][4][2], const Unit& u, int wr, int wc, int fr, int fq) const {
        const int row0 = u.pm * 256 + wr * 64 + fr;
#pragma unroll
        for (int ai = 0; ai < 2; ++ai)
#pragma unroll
            for (int m = 0; m < 4; ++m) {
                const int row = row0 + ai * 128 + m * 16, col = u.pn * 128 + wc * 32 + 8 * fq;
                f32x4 o0, o1;
#pragma unroll
                for (int j = 0; j < 4; ++j) { o0[j] = siluf_(acc[ai][0][m][0][j] * (1.0f / WSCALE)) * acc[ai][1][m][0][j] * (HSCALE / WSCALE);
                                              o1[j] = siluf_(acc[ai][0][m][1][j] * (1.0f / WSCALE)) * acc[ai][1][m][1][j] * (HSCALE / WSCALE); }
                *(u32x2*)(hh + (size_t)row * 512 + col) = pk8_fp8(o0, o1);
            }
    }
};
struct EpiExp2 {
    static constexpr bool PERM = true; static constexpr int MID_T = -1; static constexpr bool FP8 = true;
    unsigned char* y; const u32x2* wd; const bf16_t* t16; bf16_t* t16o; const float* mod;
    __device__ __forceinline__ void operator()(const f32x4 (&acc)[2][2][4][2], const Unit& u, int wr, int wc, int fr, int fq) const {
        const int row0 = u.pm * 256 + wr * 64 + fr;
        int dsts[2][4]; float wts[2][4];
#pragma unroll
        for (int ai = 0; ai < 2; ++ai)
#pragma unroll
            for (int m = 0; m < 4; ++m) { const u32x2 q = wd[row0 + ai * 128 + m * 16]; dsts[ai][m] = (int)q.y; wts[ai][m] = __uint_as_float(q.x) * (YSCALE / (WSCALE * HSCALE)); }
        if (u.e < 64) {
#pragma unroll
            for (int ai = 0; ai < 2; ++ai)
#pragma unroll
                for (int m = 0; m < 4; ++m) {
                    const int dst = dsts[ai][m]; const float w = wts[ai][m];
                    if (dst >= 0) {
                        const u32x2 lo = pk8_fp8(acc[ai][0][m][0] * w, acc[ai][0][m][1] * w), hi = pk8_fp8(acc[ai][1][m][0] * w, acc[ai][1][m][1] * w);
                        *(u32x4*)(y + (size_t)dst * 2048 + u.pn * 256 + wc * 64 + fq * 16) = (u32x4){lo.x, lo.y, hi.x, hi.y};
                    }
                }
        } else {
#pragma unroll
            for (int ai = 0; ai < 2; ++ai)
#pragma unroll
                for (int bj = 0; bj < 2; ++bj) {
                    const int col = u.pn * 256 + bj * 128 + wc * 32 + 8 * fq;
                    const float* gr = mod + (dsts[0][0] >> 13) * 12288 + 5 * 2048 + col;
                    const f32x4 g0 = *(const f32x4*)gr, g1 = *(const f32x4*)(gr + 4);
                    u32x4 xx[4];
#pragma unroll
                    for (int m = 0; m < 4; ++m) xx[m] = *(const u32x4*)(t16 + (size_t)dsts[ai][m] * 2048 + col);
#pragma unroll
                    for (int m = 0; m < 4; ++m) { float f[8]; unpack8(xx[m], f);
                        f32x4 o0, o1;
#pragma unroll
                        for (int j = 0; j < 4; ++j) { o0[j] = f[j] * DN_ALPHA + g0[j] * (acc[ai][bj][m][0][j] * (1.0f / (WSCALE * HSCALE))); o1[j] = f[4 + j] * DN_ALPHA + g1[j] * (acc[ai][bj][m][1][j] * (1.0f / (WSCALE * HSCALE))); }
                        st8_bf16(t16o + (size_t)dsts[ai][m] * 2048 + col, o0, o1); }
                }
        }
    }
};
struct Exp1Sched {
    static constexpr bool GATHER = true;
    const char* h2; const char* btgu; const int* tokof; const int* tilee; int ntiles, G, c; int lda, ldb;
    __device__ __forceinline__ bool next(int i, Unit& u) const {
        if (G == 256) { const int v = c & 7, r = c >> 3, grp = i * 8 + v, tile = grp * 8 + (r & 7); if (tile >= ntiles) return false; u.pm = tile; u.pn = r >> 3; }
        else { const int L = i * G + c; if (L >= ntiles * 4) return false; u.pm = L >> 2; u.pn = L & 3; }
        u.e = __builtin_amdgcn_readfirstlane(tilee[u.pm]); return true; }
    __device__ __forceinline__ const char* a_base(const Unit&) const { return h2; }
    __device__ __forceinline__ unsigned a_row_off(const Unit& u, int r) const { return (unsigned)tokof[u.pm * 256 + r] * 2048u; }
    __device__ __forceinline__ const char* b_base(const Unit& u) const { return btgu + ((size_t)u.e * 1024 + u.pn * 256) * 2048; }
};
struct Exp2Sched {
    static constexpr bool GATHER = false;
    const char* hh; const char* btd; const int* tilee; int ntiles, G, c; int lda, ldb;
    __device__ __forceinline__ bool next(int i, Unit& u) const {
        if (G == 256) { const int v = c & 7, r = c >> 3, grp = i * 8 + v, tile = grp * 4 + (r & 3); if (tile >= ntiles) return false; u.pm = tile; u.pn = r >> 2; }
        else { const int L = i * G + c; if (L >= ntiles * 8) return false; u.pm = L >> 3; u.pn = L & 7; }
        u.e = __builtin_amdgcn_readfirstlane(tilee[u.pm]); return true; }
    __device__ __forceinline__ const char* a_base(const Unit& u) const { return hh + (size_t)u.pm * 256 * 512; }
    __device__ __forceinline__ unsigned a_row_off(const Unit&, int) const { return 0u; }
    __device__ __forceinline__ const char* b_base(const Unit& u) const { return btd + ((size_t)u.e * 2048 + u.pn * 256) * 512; }
};
template <int NN> __device__ __forceinline__ gm::DenseSchedT<NN> dense(const void* A, int lda, const void* Bt, int ldb) {
    gm::DenseSchedT<NN> s; s.A = (const char*)A; s.Bt = (const char*)Bt; s.lda = lda; s.ldb = ldb; s.G = gridDim.x; s.c = blockIdx.x; return s; }
__device__ __forceinline__ void ph_smallnorm(const Params& p) {
    const bf16_t* psm = (const bf16_t*)(p.ws + O_PSM);
    bf16_t* cqn = (bf16_t*)(p.ws + O_CQN); bf16_t* kv = (bf16_t*)(p.ws + O_KV); bf16_t* kidx = (bf16_t*)(p.ws + O_KIDX); float* widx = (float*)(p.ws + O_WIDX);
    const int tid_ = opaque_tid(); const int lane = tid_ & 63, wv = tid_ >> 6;
    const f32x4 qg0 = *(const f32x4*)(p.qng + lane * 8), qg1 = *(const f32x4*)(p.qng + lane * 8 + 4);
    const int pc_ = lane < 16 ? lane * 8 : (lane < 24 ? (lane - 16) * 8 : 0);
    const float* gsrc = lane < 16 ? p.kvng : p.ikg;
    const f32x4 sg0 = *(const f32x4*)(gsrc + pc_), sg1 = *(const f32x4*)(gsrc + pc_ + 4), sb0 = *(const f32x4*)(p.ikb + (lane < 16 ? 0 : pc_)), sb1 = *(const f32x4*)(p.ikb + (lane < 16 ? 0 : pc_) + 4);
    const int srow0 = blockIdx.x * 8 + wv, sstride = gridDim.x * 8;
    u32x4 an = (u32x4){0u, 0u, 0u, 0u}, bn = an;
    if (srow0 < NT) { an = *(const u32x4*)(psm + (size_t)srow0 * 768 + lane * 8); if (lane < 26) bn = *(const u32x4*)(psm + (size_t)srow0 * 768 + 512 + lane * 8); }
#pragma unroll 1
    for (int row = srow0; row < NT; row += sstride) {
        const u32x4 a = an, bcur = bn;
        { const int rn = (row + sstride < NT) ? row + sstride : row; an = *(const u32x4*)(psm + (size_t)rn * 768 + lane * 8); if (lane < 26) bn = *(const u32x4*)(psm + (size_t)rn * 768 + 512 + lane * 8); }
        float f[8];
        f[0] = __uint_as_float(a.x << 16); f[1] = __uint_as_float(a.x & 0xffff0000u); f[2] = __uint_as_float(a.y << 16); f[3] = __uint_as_float(a.y & 0xffff0000u);
        f[4] = __uint_as_float(a.z << 16); f[5] = __uint_as_float(a.z & 0xffff0000u); f[6] = __uint_as_float(a.w << 16); f[7] = __uint_as_float(a.w & 0xffff0000u);
        float ss = 0.f;
#pragma unroll
        for (int j = 0; j < 8; ++j) ss += f[j] * f[j];
        const float r1 = rsqrtf(wave_sum(ss) * (1.0f / 512.0f) + LN_EPS);
        {
            const f32x4 g0 = qg0, g1 = qg1;
            u32x4 w; w.x = pk_bf16(f[0] * r1 * g0[0], f[1] * r1 * g0[1]); w.y = pk_bf16(f[2] * r1 * g0[2], f[3] * r1 * g0[3]);
            w.z = pk_bf16(f[4] * r1 * g1[0], f[5] * r1 * g1[1]); w.w = pk_bf16(f[6] * r1 * g1[2], f[7] * r1 * g1[3]);
            *(u32x4*)(cqn + (size_t)row * 512 + lane * 8) = w;
        }
        float g[8];
        {
            const u32x4 b = (lane < 26) ? bcur : (u32x4){0u, 0u, 0u, 0u};
            g[0] = __uint_as_float(b.x << 16); g[1] = __uint_as_float(b.x & 0xffff0000u); g[2] = __uint_as_float(b.y << 16); g[3] = __uint_as_float(b.y & 0xffff0000u);
            g[4] = __uint_as_float(b.z << 16); g[5] = __uint_as_float(b.z & 0xffff0000u); g[6] = __uint_as_float(b.w << 16); g[7] = __uint_as_float(b.w & 0xffff0000u);
        }
        float s1 = 0.f, s2 = 0.f;
#pragma unroll
        for (int j = 0; j < 8; ++j) { s1 += g[j]; s2 += g[j] * g[j]; }
        const float kvss = wave_sum(lane < 16 ? s2 : 0.f);
        const float kis = wave_sum((lane >= 16 && lane < 24) ? s1 : 0.f);
        const float mu = kis * (1.0f / 64.0f);
        float dq = 0.f;
#pragma unroll
        for (int j = 0; j < 8; ++j) dq += (g[j] - mu) * (g[j] - mu);
        const float kiv = wave_sum((lane >= 16 && lane < 24) ? dq : 0.f) * (1.0f / 64.0f);
        if (lane < 16) {
            const float r2 = rsqrtf(kvss * (1.0f / 128.0f) + LN_EPS);
            const f32x4 g0 = sg0, g1 = sg1;
            u32x4 w; w.x = pk_bf16(g[0] * r2 * g0[0], g[1] * r2 * g0[1]); w.y = pk_bf16(g[2] * r2 * g0[2], g[3] * r2 * g0[3]);
            w.z = pk_bf16(g[4] * r2 * g1[0], g[5] * r2 * g1[1]); w.w = pk_bf16(g[6] * r2 * g1[2], g[7] * r2 * g1[3]);
            *(u32x4*)(kv + (size_t)row * 128 + lane * 8) = w;
        } else if (lane < 24) {
            const int c = (lane - 16) * 8; const float r3 = rsqrtf(kiv + LN_EPS);
            const f32x4 g0 = sg0, g1 = sg1, b0 = sb0, b1 = sb1;
            u32x4 w; w.x = pk_bf16((g[0] - mu) * r3 * g0[0] + b0[0], (g[1] - mu) * r3 * g0[1] + b0[1]); w.y = pk_bf16((g[2] - mu) * r3 * g0[2] + b0[2], (g[3] - mu) * r3 * g0[3] + b0[3]);
            w.z = pk_bf16((g[4] - mu) * r3 * g1[0] + b1[0], (g[5] - mu) * r3 * g1[1] + b1[1]); w.w = pk_bf16((g[6] - mu) * r3 * g1[2] + b1[2], (g[7] - mu) * r3 * g1[3] + b1[3]);
            *(u32x4*)(kidx + (size_t)row * 64 + c) = w;
        } else if (lane < 26) {
            const int c = (lane - 24) * 8;
            *(f32x4*)(widx + (size_t)row * 16 + c) = (f32x4){g[0], g[1], g[2], g[3]} * 0.03125f;
            *(f32x4*)(widx + (size_t)row * 16 + c + 4) = (f32x4){g[4], g[5], g[6], g[7]} * 0.03125f;
        }
    }
}

__device__ __forceinline__ unsigned short score_key(float s) {
    const unsigned short h = __builtin_bit_cast(unsigned short, (_Float16)s);
    const unsigned short m = (unsigned short)((short)h >> 15);
    return (unsigned short)(h ^ (m | 0x8000u));
}
__device__ __forceinline__ int wave_sum_fast(int v) {
    v += __builtin_amdgcn_update_dpp(0, v, 0xB1, 0xf, 0xf, false);
    v += __builtin_amdgcn_update_dpp(0, v, 0x4E, 0xf, 0xf, false);
    v += __builtin_amdgcn_update_dpp(0, v, 0x141, 0xf, 0xf, false);
    v += __builtin_amdgcn_update_dpp(0, v, 0x140, 0xf, 0xf, false);
    u32x2 r = __builtin_amdgcn_permlane16_swap(v, v, false, false); v = r[0] + r[1];
    r = __builtin_amdgcn_permlane32_swap(v, v, false, false); v = r[0] + r[1];
    return v;
}
__device__ __forceinline__ unsigned cnt_ge4(unsigned cnt, const u32x4& v, unsigned tm1pk) {
    unsigned t0, t1, t2, t3;
    asm("v_pk_sub_u16 %0, %1, %2 clamp" : "=v"(t0) : "v"(v.x), "v"(tm1pk));
    asm("v_pk_sub_u16 %0, %1, %2 clamp" : "=v"(t1) : "v"(v.y), "v"(tm1pk));
    asm("v_pk_sub_u16 %0, %1, %2 clamp" : "=v"(t2) : "v"(v.z), "v"(tm1pk));
    asm("v_pk_sub_u16 %0, %1, %2 clamp" : "=v"(t3) : "v"(v.w), "v"(tm1pk));
    const unsigned one = 0x00010001u;
    asm("v_pk_min_u16 %0, %1, %2" : "=v"(t0) : "v"(t0), "v"(one));
    asm("v_pk_min_u16 %0, %1, %2" : "=v"(t1) : "v"(t1), "v"(one));
    asm("v_pk_min_u16 %0, %1, %2" : "=v"(t2) : "v"(t2), "v"(one));
    asm("v_pk_min_u16 %0, %1, %2" : "=v"(t3) : "v"(t3), "v"(one));
    asm("v_pk_add_u16 %0, %1, %2" : "=v"(t0) : "v"(t0), "v"(t1));
    asm("v_pk_add_u16 %0, %1, %2" : "=v"(t2) : "v"(t2), "v"(t3));
    asm("v_pk_add_u16 %0, %1, %2" : "=v"(t0) : "v"(t0), "v"(t2));
    asm("v_pk_add_u16 %0, %1, %2" : "=v"(cnt) : "v"(cnt), "v"(t0));
    return cnt;
}
typedef _Float16 h2_t __attribute__((ext_vector_type(2)));
typedef short s2_t __attribute__((ext_vector_type(2)));
__device__ __forceinline__ float relu_(float x) { return __builtin_amdgcn_fmed3f(x, 0.0f, __builtin_inff()); }
__device__ __forceinline__ void ph_indexer(const Params& p, ldsp_t lds, const int nsel_rep) {
    const bf16_t* qidx = (const bf16_t*)(p.ws + O_QIDX); const bf16_t* kidx = (const bf16_t*)(p.ws + O_KIDX); const float* widx = (const float*)(p.ws + O_WIDX);
    u16* sel = (u16*)(p.ws + O_SEL);
    LAS u16* sc = (LAS u16*)lds;
    ldsp_t kt = lds + 32768;
    unsigned bwo = LDS_BYTES - 16; asm volatile("" : "+v"(bwo));
    const LAS unsigned* bwp = (const LAS unsigned*)(lds + bwo);
    const unsigned bw0 = __builtin_amdgcn_readfirstlane(bwp[0]), bw1 = __builtin_amdgcn_readfirstlane(bwp[1]), bw2 = __builtin_amdgcn_readfirstlane(bwp[2]), bw3 = __builtin_amdgcn_readfirstlane(bwp[3]);
    __syncthreads();
    const int tid = opaque_tid(), lane = tid & 63, wv = __builtin_amdgcn_readfirstlane(tid >> 6), rb = wv & 3, kb = wv >> 2;
    const int l31 = lane & 31, hh = lane >> 5;
    const int drow = 8 * wv + (lane >> 3), dchunk = (lane & 7) ^ ((drow >> 1) & 7);
    const int krow = kb * 32 + l31;
    unsigned boff[4];
#pragma unroll
    for (int kk = 0; kk < 4; ++kk) boff[kk] = (unsigned)(krow * 128 + (((2 * kk + hh) ^ ((krow >> 1) & 7)) * 16));
    typedef float f32x16 __attribute__((ext_vector_type(16)));
    const bool xmap = gridDim.x == 256;
    const int xwi = ((blockIdx.x & 1) * 32) + (blockIdx.x >> 3);
    for (int ui = 0;; ++ui) {
        int b, qt;
        if (xmap) { if (ui >= 16) break; b = (blockIdx.x & 7) >> 1; qt = 1023 - (((ui & 1) ? 63 - xwi : xwi) + 64 * ui); }
        else { const int unit = blockIdx.x + ui * gridDim.x; if (unit >= NT / 8) break; b = unit & 3; qt = 1023 - (unit >> 2); }
        const int t0 = qt * 8, g0 = b * SEQ + t0;
        const int nkeys = ((t0 + 8 + 511) >> 9) << 9;
        const int nst = nkeys >> 8;
        bf16x8 af[4];
        {
            const int row = l31, q = 2 * rb + (row >> 4), h = row & 15;
            const bf16_t* src = qidx + (size_t)(g0 + q) * 1024 + h * 64 + 8 * hh;
#pragma unroll
            for (int kk = 0; kk < 4; ++kk) af[kk] = *(const bf16x8*)(src + 16 * kk);
        }
        h2_t wq0[4], wq1[4];
#pragma unroll
        for (int i = 0; i < 4; ++i) { const int h = ((2 * i) & 3) + 8 * ((2 * i) >> 2) + 4 * hh;
            wq0[i] = (h2_t){(_Float16)widx[(size_t)(g0 + 2 * rb) * 16 + h], (_Float16)widx[(size_t)(g0 + 2 * rb) * 16 + h + 1]};
            wq1[i] = (h2_t){(_Float16)widx[(size_t)(g0 + 2 * rb + 1) * 16 + h], (_Float16)widx[(size_t)(g0 + 2 * rb + 1) * 16 + h + 1]}; }
        const int myq = t0 + 2 * rb + hh;
        const bf16_t* ksrc = kidx + ((size_t)b * SEQ + drow) * 64 + dchunk * 8;
        LAS u16* scw = sc + (2 * rb + hh) * 2048 + kb * 32 + l31;
        const int t = t0 + wv, n = t + 1;
        const int nch = (n + 511) >> 9;
        const LAS u16* srow = sc + wv * 2048;
        u32x4 kr[16];
#pragma unroll
        for (int ch = 0; ch < 16; ++ch) kr[ch] = (u32x4){0u, 0u, 0u, 0u};
        auto score_pass = [&](const int s0, const int s1) {
            asm volatile("s_waitcnt lgkmcnt(0)" ::: "memory");
            __builtin_amdgcn_s_barrier(); asm volatile("" ::: "memory");
            if (s0 == 0) {
#pragma unroll
                for (int j = 0; j < 4; ++j) __builtin_amdgcn_global_load_lds((const unsigned*)(ksrc + (size_t)(j) * 4096), (LAS unsigned*)(kt + j * 8192 + wv * 1024), 16, 0, 0);
#pragma unroll
                for (int j = 0; j < 4; ++j) __builtin_amdgcn_global_load_lds((const unsigned*)(ksrc + (size_t)(4 + j) * 4096), (LAS unsigned*)(kt + 32768 + j * 8192 + wv * 1024), 16, 0, 0);
                if (2 < nst) {
#pragma unroll
                    for (int j = 0; j < 4; ++j) __builtin_amdgcn_global_load_lds((const unsigned*)(ksrc + (size_t)(8 + j) * 4096), (LAS unsigned*)(kt + 65536 + j * 8192 + wv * 1024), 16, 0, 0);
                    asm volatile("s_waitcnt vmcnt(8)" ::: "memory");
                } else asm volatile("s_waitcnt vmcnt(4)" ::: "memory");
            }
            asm volatile("" : "+v"(af[0]), "+v"(af[1]), "+v"(af[2]), "+v"(af[3]));
            asm volatile("" : "+v"(wq0[0]), "+v"(wq0[1]), "+v"(wq0[2]), "+v"(wq0[3]), "+v"(wq1[0]), "+v"(wq1[1]), "+v"(wq1[2]), "+v"(wq1[3]));
            __builtin_amdgcn_s_barrier(); asm volatile("" ::: "memory");
            int slot = 0;
#pragma unroll 1
            for (int st = s0; st < s1; ++st) {
                const int ahead = nst - 1 - st;
                if (ahead >= 3) { const int ns = (slot + 98304) & 131071;
#pragma unroll
                    for (int j = 0; j < 4; ++j) __builtin_amdgcn_global_load_lds((const unsigned*)(ksrc + (size_t)((st + 3) * 4 + j) * 4096), (LAS unsigned*)(kt + ns + j * 8192 + wv * 1024), 16, 0, 0);
                }
                ldsp_t kb_ = kt + slot;
                const f32x16 zero16 = {0.f, 0.f, 0.f, 0.f, 0.f, 0.f, 0.f, 0.f, 0.f, 0.f, 0.f, 0.f, 0.f, 0.f, 0.f, 0.f};
#define SC_MMA(ACC, j_) do { bf16x8 bq_[4]; _Pragma("unroll") for (int kk = 0; kk < 4; ++kk) bq_[kk] = *(const LAS bf16x8*)(kb_ + (j_) * 8192 + boff[kk]); \
                    asm volatile("" : "+v"(bq_[0]), "+v"(bq_[1]), "+v"(bq_[2]), "+v"(bq_[3]));     \
                    ACC = zero16; _Pragma("unroll") for (int kk = 0; kk < 4; ++kk) ACC = __builtin_amdgcn_mfma_f32_32x32x16_bf16(af[kk], bq_[kk], ACC, 0, 0, 0); } while (0)
#define SC_TILE(ACC, j_) do { float sa = 0.f, sb = 0.f; \
                    _Pragma("unroll") for (int i = 0; i < 4; ++i) { \
                        const s2_t ra = __builtin_elementwise_max(__builtin_bit_cast(s2_t, __builtin_amdgcn_cvt_pkrtz(ACC[2 * i], ACC[2 * i + 1])), (s2_t){0, 0}); \
                        const s2_t rb_ = __builtin_elementwise_max(__builtin_bit_cast(s2_t, __builtin_amdgcn_cvt_pkrtz(ACC[8 + 2 * i], ACC[9 + 2 * i])), (s2_t){0, 0}); \
                        sa = __builtin_amdgcn_fdot2(__builtin_bit_cast(h2_t, ra), wq0[i], sa, false); \
                        sb = __builtin_amdgcn_fdot2(__builtin_bit_cast(h2_t, rb_), wq1[i], sb, false); } \
                    const u32x2 sw = __builtin_amdgcn_permlane32_swap(__float_as_uint(sa), __float_as_uint(sb), false, false); \
                    const float s = __uint_as_float(sw[0]) + __uint_as_float(sw[1]); \
                    const int kidx_ = st * 256 + (j_) * 64 + kb * 32 + l31; \
                    scw[(st - s0) * 256 + (j_) * 64] = (kidx_ <= myq) ? score_key(s) : (unsigned short)0; } while (0)
                f32x16 accA, accB;
                SC_MMA(accA, 0);
                SC_MMA(accB, 1); SC_TILE(accA, 0);
                SC_MMA(accA, 2); SC_TILE(accB, 1);
                SC_MMA(accB, 3); SC_TILE(accA, 2);
                SC_TILE(accB, 3);
#undef SC_MMA
#undef SC_TILE
                slot = (slot + 32768) & 131071;
                if (ahead >= 3) asm volatile("s_waitcnt vmcnt(8) lgkmcnt(0)" ::: "memory");
                else if (ahead == 2) asm volatile("s_waitcnt vmcnt(4) lgkmcnt(0)" ::: "memory");
                else asm volatile("s_waitcnt vmcnt(0) lgkmcnt(0)" ::: "memory");
                __builtin_amdgcn_s_barrier(); asm volatile("" ::: "memory");
            }
        };
#define IDX_PASS(P) if (nst > 8 * (P)) { score_pass(8 * (P), nst < 8 * (P) + 8 ? nst : 8 * (P) + 8); \
            _Pragma("unroll") for (int ch = 4 * (P); ch < 4 * (P) + 4; ++ch) if (ch < nch) kr[ch] = *(const LAS u32x4*)(srow + (ch - 4 * (P)) * 512 + lane * 8); }
        IDX_PASS(0) IDX_PASS(1) IDX_PASS(2) IDX_PASS(3)
#undef IDX_PASS
        if (nsel_rep) {
            u16* sog = sel + (size_t)(g0 + wv) * 256;
            LAS u16* so = (LAS u16*)(kt + wv * 512);
            if (n <= 256) {
#pragma unroll
                for (int i = 0; i < 4; ++i) { const int j = i * 64 + lane; so[j] = (u16)(j < n ? j : 0); }
            } else {
                unsigned T = 0;
#pragma unroll 1
                for (int bit = 15; bit >= 0; --bit) {
                    const unsigned Tc = T | (1u << bit), tm1 = Tc - 1u, tpk = tm1 | (tm1 << 16);
                    unsigned c2 = 0;
#pragma unroll
                    for (int ch = 0; ch < 4; ++ch) c2 = cnt_ge4(c2, kr[ch], tpk);
                    if (nch > 4) {
#pragma unroll
                        for (int ch = 4; ch < 8; ++ch) c2 = cnt_ge4(c2, kr[ch], tpk);
                        if (nch > 8) {
#pragma unroll
                            for (int ch = 8; ch < 12; ++ch) c2 = cnt_ge4(c2, kr[ch], tpk);
                            if (nch > 12) {
#pragma unroll
                                for (int ch = 12; ch < 16; ++ch) c2 = cnt_ge4(c2, kr[ch], tpk);
                            }
                        }
                    }
                    const int cnt = __builtin_amdgcn_readfirstlane(wave_sum_fast((int)(c2 & 0xffffu) + (int)(c2 >> 16)));
                    if (cnt >= TOPK) T = Tc;
                    if (cnt == TOPK) break;
                }
                int base = 0;
                const unsigned long long lt = (1ull << lane) - 1ull;
#pragma unroll
                for (int ch = 0; ch < 16; ++ch) {
                    if (ch < nch) {
#pragma unroll
                        for (int j = 0; j < 8; ++j) {
                            const unsigned d = kr[ch][j >> 1]; const unsigned key = (j & 1) ? (d >> 16) : (d & 0xffffu);
                            const bool gt = key > T;
                            const unsigned long long m = __ballot(gt);
                            if (gt) so[base + __popcll(m & lt)] = (u16)(ch * 512 + lane * 8 + j);
                            base += __popcll(m);
                        }
                    }
                }
                int need = TOPK - base;
#pragma unroll
                for (int ch = 0; ch < 16; ++ch) {
                    if (ch < nch && need > 0) {
                        const unsigned tpk2 = T | (T << 16);
                        bool anyeq = false;
#pragma unroll
                        for (int dq = 0; dq < 4; ++dq) { const unsigned x = kr[ch][dq] ^ tpk2; anyeq |= ((x & 0xffffu) == 0u) | ((x >> 16) == 0u); }
                        if (__ballot(anyeq) == 0ull) continue;
#pragma unroll
                        for (int j = 0; j < 8; ++j) {
                            const unsigned d = kr[ch][j >> 1]; const unsigned key = (j & 1) ? (d >> 16) : (d & 0xffffu);
                            const bool eq = key == T;
                            const unsigned long long m = __ballot(eq);
                            const int rk = __popcll(m & lt);
                            if (eq && rk < need) so[base + rk] = (u16)(ch * 512 + lane * 8 + j);
                            const int tk = __popcll(m); const int took = tk < need ? tk : need;
                            base += took; need -= took;
                        }
                    }
                }
            }
            *(u32x2*)(sog + lane * 4) = *(const LAS u32x2*)(so + lane * 4);
        }
    }
    asm volatile("s_waitcnt vmcnt(0) lgkmcnt(0)" ::: "memory");
    __syncthreads();
    if (opaque_tid() == 0) *(LAS u32x4*)(lds + LDS_BYTES - 16) = (u32x4){bw0, bw1, bw2, bw3};
    __syncthreads();
}

__device__ __forceinline__ unsigned kv_off(unsigned row, unsigned ch) { return 256u * row + 16u * (ch ^ (((row & 3) << 2) | ((row >> 2) & 3))); }
__device__ __forceinline__ void ph_attn(const Params& p, ldsp_t lds) {
    const bf16_t* qlat = (const bf16_t*)(p.ws + O_QLAT); const bf16_t* kv = (const bf16_t*)(p.ws + O_KV); const u16* sel = (const u16*)(p.ws + O_SEL);
    bf16_t* olat = (bf16_t*)(p.ws + O_OLAT);
    const int tid = opaque_tid(), lane = tid & 63, wv = __builtin_amdgcn_readfirstlane(tid >> 6);
    ldsp_t img = lds + wv * 8192;
    LAS u16* selB = (LAS u16*)(lds + 65536 + wv * 1024);
    LAS float* tab = (LAS float*)(lds + 65536 + 8192);
    for (int i = tid; i < 2048; i += NTHREADS) { const int d = i >> 4; int bk; if (d < 16) bk = d; else { bk = 16 + (int)(__log2f((float)d * 0.0625f) * (16.0f / 3.0f)); if (bk > 31) bk = 31; }
        tab[i] = p.rpb[bk * 16 + (i & 15)]; }
    __syncthreads();
    const int hd = lane & 15, g = lane >> 4;
    const bool xmap = gridDim.x == 256;
    const int qstride = xmap ? 512 : (int)gridDim.x * 8;
    const int tok0 = xmap ? (((blockIdx.x & 7) >> 1) * SEQ + (((blockIdx.x & 1) * 32 + (blockIdx.x >> 3)) * 8) + wv) : (int)(blockIdx.x * 8 + wv);
    const int tok_end = xmap ? (((blockIdx.x & 7) >> 1) + 1) * SEQ : NT;
    const int nq = tok0 < tok_end ? (tok_end - tok0 + qstride - 1) / qstride : 0;
    const int nchunks = nq * 8;
    u32x4 stA[8], stB[8];
#define ATT_GATHER(ST, n_) do { const int qi_ = (n_) >> 3, ch_ = (n_) & 7; const int tk_ = tok0 + qi_ * qstride; const bf16_t* kvb_ = kv + (size_t)(tk_ >> 13) * SEQ * 128; \
        _Pragma("unroll") for (int it = 0; it < 8; ++it) { const int pc = it * 64 + lane, r = pc >> 4, c16 = pc & 15; const int ki = selB[(qi_ & 1) * 256 + ch_ * 32 + r]; \
            ST[it] = *(const u32x4*)(kvb_ + (size_t)ki * 128 + c16 * 8); } } while (0)
#define ATT_STAGE(ST) do { _Pragma("unroll") for (int it = 0; it < 8; ++it) { const int pc = it * 64 + lane, r = pc >> 4, c16 = pc & 15; *(LAS u32x4*)(img + kv_off(r, c16)) = ST[it]; } } while (0)
    bf16x8 qf[4];
    if (nq > 0) {
        const u32x2 s4 = *(const u32x2*)(sel + (size_t)tok0 * 256 + lane * 4); *(LAS u32x2*)(selB + lane * 4) = s4;
#pragma unroll
        for (int kk = 0; kk < 4; ++kk) qf[kk] = *(const bf16x8*)(qlat + (size_t)tok0 * 2048 + hd * 128 + 32 * kk + 8 * g);
        ATT_GATHER(stA, 0); ATT_GATHER(stB, 1);
    }
#pragma unroll 1
    for (int qi = 0; qi < nq; ++qi) {
        const int tok = tok0 + qi * qstride, t = tok & (SEQ - 1);
        const int nsel = (t + 1) < TOPK ? (t + 1) : TOPK;
        const int buf = qi & 1;
        const int tokn = (qi + 1 < nq) ? tok + qstride : tok;
        const u32x2 sn = *(const u32x2*)(sel + (size_t)tokn * 256 + lane * 4);
        bf16x8 qn[4];
#pragma unroll
        for (int kk = 0; kk < 4; ++kk) qn[kk] = *(const bf16x8*)(qlat + (size_t)tokn * 2048 + hd * 128 + 32 * kk + 8 * g);
        f32x4 o[8];
#pragma unroll
        for (int mb = 0; mb < 8; ++mb) o[mb] = (f32x4){0.f, 0.f, 0.f, 0.f};
        float mrun = -1e30f, lrun = 0.f;
        auto compute = [&](const int ch) {
            float bias[2][4];
#pragma unroll
            for (int blk = 0; blk < 2; ++blk) {
                const u32x2 k4 = *(const LAS u32x2*)(selB + buf * 256 + ch * 32 + 16 * blk + 4 * g);
#pragma unroll
                for (int r = 0; r < 4; ++r) {
                    const int pos = ch * 32 + 16 * blk + 4 * g + r;
                    const int ki = (int)(((r & 2) ? k4.y : k4.x) >> ((r & 1) * 16)) & 0xffff;
                    int dist = t - ki; dist = dist < 0 ? 0 : (dist > 127 ? 127 : dist);
                    float tv = tab[dist * 16 + hd]; asm volatile("" : "+v"(tv));
                    bias[blk][r] = (pos < nsel) ? tv : -1e30f;
                }
            }
            f32x4 s[2];
#pragma unroll
            for (int blk = 0; blk < 2; ++blk) {
                s[blk] = (f32x4){0.f, 0.f, 0.f, 0.f};
#pragma unroll
                for (int kk = 0; kk < 4; ++kk) {
                    const bf16x8 a = *(const LAS bf16x8*)(img + kv_off(hd + 16 * blk, 4 * kk + g));
                    s[blk] = __builtin_amdgcn_mfma_f32_16x16x32_bf16(a, qf[kk], s[blk], 0, 0, 0);
                }
            }
            float mx = -1e30f;
#pragma unroll
            for (int blk = 0; blk < 2; ++blk)
#pragma unroll
                for (int r = 0; r < 4; ++r) { const float v = s[blk][r] + bias[blk][r]; s[blk][r] = v; mx = fmaxf(mx, v); }
            { u32x2 rr = __builtin_amdgcn_permlane16_swap(__float_as_uint(mx), __float_as_uint(mx), false, false); mx = fmaxf(__uint_as_float(rr[0]), __uint_as_float(rr[1]));
              rr = __builtin_amdgcn_permlane32_swap(__float_as_uint(mx), __float_as_uint(mx), false, false); mx = fmaxf(__uint_as_float(rr[0]), __uint_as_float(rr[1])); }
            const float mnew = fmaxf(mrun, mx), scl = __expf(mrun - mnew);
            float ps = 0.f;
#pragma unroll
            for (int blk = 0; blk < 2; ++blk)
#pragma unroll
                for (int r = 0; r < 4; ++r) { const float e = __expf(s[blk][r] - mnew); s[blk][r] = e; ps += e; }
            { u32x2 rr = __builtin_amdgcn_permlane16_swap(__float_as_uint(ps), __float_as_uint(ps), false, false); ps = __uint_as_float(rr[0]) + __uint_as_float(rr[1]);
              rr = __builtin_amdgcn_permlane32_swap(__float_as_uint(ps), __float_as_uint(ps), false, false); ps = __uint_as_float(rr[0]) + __uint_as_float(rr[1]); }
            lrun = lrun * scl + ps; mrun = mnew;
#pragma unroll
            for (int mb = 0; mb < 8; ++mb) o[mb] *= scl;
            bf16x8 pf;
            { const u32x4 w = (u32x4){pk_bf16(s[0][0], s[0][1]), pk_bf16(s[0][2], s[0][3]), pk_bf16(s[1][0], s[1][1]), pk_bf16(s[1][2], s[1][3])}; pf = __builtin_bit_cast(bf16x8, w); }
#pragma unroll
            for (int mb = 0; mb < 8; ++mb) {
                const unsigned qq = (lane & 15) >> 2, pp = lane & 3;
                const unsigned a0 = kv_off(4 * g + qq, 2 * mb + (pp >> 1)) + 8 * (pp & 1);
                const unsigned a1 = kv_off(16 + 4 * g + qq, 2 * mb + (pp >> 1)) + 8 * (pp & 1);
                const s16x4 t0_ = __builtin_amdgcn_ds_read_tr16_b64_v4i16((LAS s16x4*)(img + a0));
                const s16x4 t1_ = __builtin_amdgcn_ds_read_tr16_b64_v4i16((LAS s16x4*)(img + a1));
                const bf16x8 af = (bf16x8){t0_[0], t0_[1], t0_[2], t0_[3], t1_[0], t1_[1], t1_[2], t1_[3]};
                o[mb] = __builtin_amdgcn_mfma_f32_16x16x32_bf16(af, pf, o[mb], 0, 0, 0);
            }
        };
#pragma unroll
        for (int ch = 0; ch < 8; ch += 2) {
            const int n = qi * 8 + ch;
            if (ch == 4) *(LAS u32x2*)(selB + (buf ^ 1) * 256 + lane * 4) = sn;
            ATT_STAGE(stA);
            if (n + 2 < nchunks) ATT_GATHER(stA, n + 2);
            compute(ch);
            ATT_STAGE(stB);
            if (n + 3 < nchunks) ATT_GATHER(stB, n + 3);
            compute(ch + 1);
        }
        const float inv = OSCALE / lrun;
        unsigned w8[8];
#pragma unroll
        for (int mb = 0; mb < 8; ++mb) {
            int w = 0; w = __builtin_amdgcn_cvt_pk_fp8_f32(o[mb][0] * inv, o[mb][1] * inv, w, false); w = __builtin_amdgcn_cvt_pk_fp8_f32(o[mb][2] * inv, o[mb][3] * inv, w, true); w8[mb] = (unsigned)w; }
        *(u32x4*)((unsigned char*)olat + (size_t)tok * 3072 + hd * 128 + g * 32) = (u32x4){w8[0], w8[1], w8[2], w8[3]};
        *(u32x4*)((unsigned char*)olat + (size_t)tok * 3072 + hd * 128 + g * 32 + 16) = (u32x4){w8[4], w8[5], w8[6], w8[7]};
#pragma unroll
        for (int kk = 0; kk < 4; ++kk) qf[kk] = qn[kk];
    }
#undef ATT_GATHER
#undef ATT_STAGE
    __syncthreads();
}
namespace hg {
constexpr int L_QT = 0, L_KT = 4096, L_KHT = 8192, L_VT = 16384, L_DV = 24576, L_ATT = 25088, L_SSQ = 33280, L_RAW = 33792, L_END = L_RAW + 2 * 12288;
__device__ __forceinline__ unsigned off16(unsigned row, unsigned ch) { return 256u * row + 16u * (ch ^ (((row & 3) << 2) | ((row >> 2) & 3))); }
__device__ __forceinline__ unsigned offT(unsigned row, unsigned ch) { return 64u * row + 16u * (ch ^ ((row >> 2) & 3)); }

template <int PASS>
__device__ __forceinline__ void run(const Params& p, ldsp_t lds) {
    const _Float16* LF = (const _Float16*)(p.ws + O_LF); const bf16_t* QB = (const bf16_t*)(p.ws + O_QB); const bf16_t* VV = (const bf16_t*)(p.ws + O_V); const bf16_t* GG = (const bf16_t*)(p.ws + O_G);
    float* HST = (float*)(p.ws + O_HST); float* HDEC = (float*)(p.ws + O_HDEC); bf16_t* OB = (bf16_t*)(p.ws + O_OLAT);
    const int tid = opaque_tid(), lane = tid & 63, wv = __builtin_amdgcn_readfirstlane(tid >> 6);
    const int l15 = lane & 15, g = lane >> 4;
    const int k = tid & 127, ig = tid >> 7;
    for (int i = tid; i < (L_ATT + 8192 - L_KHT) / 16; i += NTHREADS) *(LAS u32x4*)(lds + L_KHT + i * 16) = (u32x4){0u, 0u, 0u, 0u};
    __syncthreads();
    for (int s = blockIdx.x; s < 256; s += gridDim.x) {
        const int seg = s & 7, h = (s >> 3) & 7, b = s >> 6;
        if (PASS == 1 && seg == 7) continue;
        const size_t tok0 = (size_t)b * SEQ + (size_t)seg * HSEGL;
        const size_t cbase = (size_t)h * 128;
        f32x4 S[8];
#pragma unroll
        for (int mb = 0; mb < 8; ++mb) S[mb] = (f32x4){0.f, 0.f, 0.f, 0.f};
        if (PASS == 3) {
#pragma unroll 2
            for (int gp = 0; gp < seg; ++gp) {
                const int sp = (s & ~7) + gp;
                const float* Lp = HST + ((size_t)sp * 512 + tid) * 32; const float* Dp = HDEC + (size_t)sp * 128 + 4 * g;
#pragma unroll
                for (int mb = 0; mb < 8; ++mb) S[mb] = S[mb] * *(const f32x4*)(Dp + 16 * mb) + *(const f32x4*)(Lp + 4 * mb);
            }
        }
        float lfsum = 0.f;
        const float gn = (PASS == 3) ? p.hong[16 * wv + l15] : 0.f;
        const int rrow = tid >> 5, rc4 = (tid & 31) * 4;
        const unsigned goff0 = (unsigned)(rrow * 1024 + rc4);
        const _Float16* lfb = LF + tok0 * 1024 + cbase; const bf16_t* vbp = VV + tok0 * 1024 + cbase; const bf16_t* qbp = QB + tok0 * 1024 + cbase;
        const unsigned rawo = (unsigned)(rrow * 256 + rc4 * 2);
        u32x2 rl, rv, rq = (u32x2){0u, 0u};
        rl = *(const u32x2*)(lfb + goff0); rv = *(const u32x2*)(vbp + goff0); if (PASS == 3) rq = *(const u32x2*)(qbp + goff0);
        __syncthreads();
        *(LAS u32x2*)(lds + L_RAW + rawo) = rl; *(LAS u32x2*)(lds + L_RAW + 4096 + rawo) = rv; if (PASS == 3) *(LAS u32x2*)(lds + L_RAW + 8192 + rawo) = rq;
        rl = *(const u32x2*)(lfb + goff0 + 16 * 1024); rv = *(const u32x2*)(vbp + goff0 + 16 * 1024); if (PASS == 3) rq = *(const u32x2*)(qbp + goff0 + 16 * 1024);
        __syncthreads();
#pragma unroll 1
        for (int mc = 0; mc < HSEGL / 16; ++mc) {
            const size_t tb = tok0 + (size_t)mc * 16;
            bf16_t gq[4] = {0, 0, 0, 0};
            if (PASS == 3) {
#pragma unroll
                for (int r = 0; r < 4; ++r) gq[r] = GG[(tb + 4 * g + r) * 1024 + cbase + 16 * wv + l15];
            }
            {
                ldsp_t raw = lds + L_RAW + (mc & 1) * 12288;
                float btot = 0.f, bpre = 0.f;
#pragma unroll
                for (int i = 0; i < 16; ++i) { const float x = (float)*(const LAS _Float16*)(raw + i * 256 + k * 2); btot += x; bpre += (i < 4 * ig) ? x : 0.f; }
                lfsum += btot;
                unsigned khp[2], vtp[2];
                float bi = bpre;
#pragma unroll
                for (int i = 0; i < 4; ++i) {
                    const int ti = 4 * ig + i;
                    const float lfi = (float)*(const LAS _Float16*)(raw + (4 * ig + i) * 256 + k * 2);
                    bi += lfi;
                    const float kk_ = 1.0f - __expf(lfi);
                    const float kh = kk_ * __expf(btot - bi);
                    if (PASS == 3) {
                        const float qt = bf2f(*(const LAS bf16_t*)(raw + 8192 + (4 * ig + i) * 256 + k * 2)) * __expf(bi);
                        const float kt = kk_ * __expf(fminf(-bi, 85.0f));
                        *(LAS bf16_t*)(lds + L_QT + off16(ti, k >> 3) + (k & 7) * 2) = f2bf(qt);
                        *(LAS bf16_t*)(lds + L_KT + off16(ti, k >> 3) + (k & 7) * 2) = f2bf(kt);
                    }
                    const unsigned khb = f2bf(kh), vb_ = *(const LAS bf16_t*)(raw + 4096 + (4 * ig + i) * 256 + k * 2);
                    if (i & 1) { khp[i >> 1] |= khb << 16; vtp[i >> 1] |= vb_ << 16; } else { khp[i >> 1] = khb; vtp[i >> 1] = vb_; }
                }
                *(LAS u32x2*)(lds + L_KHT + offT(k, ig >> 1) + 8 * (ig & 1)) = (u32x2){khp[0], khp[1]};
                *(LAS u32x2*)(lds + L_VT + offT(k, ig >> 1) + 8 * (ig & 1)) = (u32x2){vtp[0], vtp[1]};
                if (ig == 0) *(LAS float*)(lds + L_DV + k * 4) = __expf(btot);
            }
            __syncthreads();
            const bf16x8 vb = *(const LAS bf16x8*)(lds + L_VT + offT(16 * wv + l15, g));
            f32x4 o = (f32x4){0.f, 0.f, 0.f, 0.f};
            if (PASS == 3) {
                f32x4 att = (f32x4){0.f, 0.f, 0.f, 0.f};
#pragma unroll
                for (int kk = 0; kk < 4; ++kk) {
                    const bf16x8 a = *(const LAS bf16x8*)(lds + L_QT + off16(l15, 4 * kk + g));
                    const bf16x8 bb = *(const LAS bf16x8*)(lds + L_KT + off16(l15, 4 * kk + g));
                    att = __builtin_amdgcn_mfma_f32_16x16x32_bf16(a, bb, att, 0, 0, 0);
                }
                ldsp_t al_ = lds + L_ATT + wv * 1024;
#pragma unroll
                for (int r = 0; r < 4; ++r) { const int t = 4 * g + r; const float v = (l15 <= t) ? att[r] : 0.f; *(LAS bf16_t*)(al_ + t * 64 + l15 * 2) = f2bf(v); }
#pragma unroll
                for (int kk = 0; kk < 4; ++kk) {
                    const u32x2 q0 = *(const LAS u32x2*)(lds + L_QT + off16(l15, 4 * kk + (g >> 1)) + 8 * (g & 1));
                    const u32x2 q1 = *(const LAS u32x2*)(lds + L_QT + off16(l15, 4 * kk + 2 + (g >> 1)) + 8 * (g & 1));
                    const u32x4 aw = (u32x4){q0.x, q0.y, q1.x, q1.y};
                    const u32x4 sw = (u32x4){pk_bf16(S[2 * kk][0], S[2 * kk][1]), pk_bf16(S[2 * kk][2], S[2 * kk][3]), pk_bf16(S[2 * kk + 1][0], S[2 * kk + 1][1]), pk_bf16(S[2 * kk + 1][2], S[2 * kk + 1][3])};
                    o = __builtin_amdgcn_mfma_f32_16x16x32_bf16(__builtin_bit_cast(bf16x8, aw), __builtin_bit_cast(bf16x8, sw), o, 0, 0, 0);
                }
                const bf16x8 aa = *(const LAS bf16x8*)(al_ + l15 * 64 + g * 16);
                o = __builtin_amdgcn_mfma_f32_16x16x32_bf16(aa, vb, o, 0, 0, 0);
            }
#pragma unroll
            for (int mb = 0; mb < 8; ++mb) {
                const f32x4 dv = *(const LAS f32x4*)(lds + L_DV + (16 * mb + 4 * g) * 4);
                const bf16x8 a = *(const LAS bf16x8*)(lds + L_KHT + offT(16 * mb + l15, g));
                S[mb] = __builtin_amdgcn_mfma_f32_16x16x32_bf16(a, vb, S[mb] * dv, 0, 0, 0);
            }
            {
                ldsp_t rn = lds + L_RAW + ((mc + 1) & 1) * 12288;
                *(LAS u32x2*)(rn + rawo) = rl; *(LAS u32x2*)(rn + 4096 + rawo) = rv; if (PASS == 3) *(LAS u32x2*)(rn + 8192 + rawo) = rq;
                if (mc + 2 < HSEGL / 16) { const unsigned go = goff0 + (unsigned)(mc + 2) * 16 * 1024;
                    rl = *(const u32x2*)(lfb + go); rv = *(const u32x2*)(vbp + go); if (PASS == 3) rq = *(const u32x2*)(qbp + go); }
            }
            if (PASS == 3) {
#pragma unroll
                for (int r = 0; r < 4; ++r) { float q = o[r] * o[r]; q += DPPF(q, 0xB1); q += DPPF(q, 0x4E); q += DPPF(q, 0x141); q += DPPF(q, 0x140);
                    if (l15 == 0) *(LAS float*)(lds + L_SSQ + ((4 * g + r) * 8 + wv) * 4) = q; }
            }
            __syncthreads();
            if (PASS == 3) {
#pragma unroll
                for (int r = 0; r < 4; ++r) {
                    const int t = 4 * g + r;
                    const f32x4 s0 = *(const LAS f32x4*)(lds + L_SSQ + t * 32), s1 = *(const LAS f32x4*)(lds + L_SSQ + t * 32 + 16);
                    const float tot = ((s0[0] + s0[1]) + (s0[2] + s0[3])) + ((s1[0] + s1[1]) + (s1[2] + s1[3]));
                    const float rstd = rsqrtf(tot * (1.0f / 128.0f) + LN_EPS);
                    const size_t gi = (tb + t) * 1024 + cbase + 16 * wv + l15;
                    ((unsigned char*)OB)[(tb + t) * 3072 + 2048 + cbase + 16 * wv + l15] = f2fp8(o[r] * rstd * gn * bf2f(gq[r]) * OSCALE);
                }
            }
        }
        if (PASS == 1) {
            float* Lp = HST + ((size_t)s * 512 + tid) * 32;
#pragma unroll
            for (int mb = 0; mb < 8; ++mb) *(f32x4*)(Lp + 4 * mb) = S[mb];
            if (ig == 0) HDEC[(size_t)s * 128 + k] = __expf(lfsum);
        }
        __syncthreads();
    }
}
}
__device__ __forceinline__ void ph_ln1(const Params& p, ldsp_t lds) {
    const float* mod = (const float*)(p.ws + O_MOD);
    bf16_t* h2 = (bf16_t*)(p.ws + O_H2); const bf16_t* r16 = (const bf16_t*)(p.ws + O_R16); unsigned char* h28 = p.ws + O_H28; bf16_t* t16 = (bf16_t*)(p.ws + O_T16);
    const int tid_ = opaque_tid(); const int lane = tid_ & 63, wv = tid_ >> 6;
    const bool bmap = gridDim.x == 256;
    const int row0 = bmap ? ((int)(blockIdx.x & 3) * SEQ + (int)(blockIdx.x >> 2) * 8 + wv) : (int)blockIdx.x * 8 + wv;
    const int rstride = bmap ? 512 : (int)gridDim.x * 8, rend = bmap ? ((int)(blockIdx.x & 3) + 1) * SEQ : NT;
    LAS float* pg = (LAS float*)lds; LAS float* pb = pg + 2048; LAS float* psh = pg + 4096; LAS float* psc = pg + 6144;
    __syncthreads();
    for (int i = tid_; i < 2048; i += NTHREADS) { pg[i] = p.ln1g[i]; pb[i] = p.ln1b[i]; }
    if (bmap) { const int b = blockIdx.x & 3; for (int i = tid_; i < 2048; i += NTHREADS) { psh[i] = mod[b * 12288 + 3 * 2048 + i]; psc[i] = mod[b * 12288 + 4 * 2048 + i] + 1.0f; } }
    else { for (int i = tid_; i < 4 * 2048; i += NTHREADS) { const int b = i >> 11, c = i & 2047; psh[8192 + b * 4096 + c] = mod[b * 12288 + 3 * 2048 + c]; psh[8192 + b * 4096 + 2048 + c] = mod[b * 12288 + 4 * 2048 + c] + 1.0f; } }
    __syncthreads();
    u32x4 gn[4];
    if (row0 < rend) {
#pragma unroll
        for (int i = 0; i < 4; ++i) gn[i] = *(const u32x4*)(r16 + (size_t)row0 * 2048 + (i * 64 + lane) * 8);
    }
#pragma unroll 1
    for (int row = row0; row < rend; row += rstride) {
        const LAS float* sh = bmap ? psh : psh + 8192 + (row >> 13) * 4096; const LAS float* sc = bmap ? psc : sh + 2048;
        f32x4 v[8]; float s = 0.f;
#pragma unroll
        for (int i = 0; i < 4; ++i) {
            const u32x4 g = gn[i];
            v[2 * i] = (f32x4){__uint_as_float(g.x << 16), __uint_as_float(g.x & 0xffff0000u), __uint_as_float(g.y << 16), __uint_as_float(g.y & 0xffff0000u)};
            v[2 * i + 1] = (f32x4){__uint_as_float(g.z << 16), __uint_as_float(g.z & 0xffff0000u), __uint_as_float(g.w << 16), __uint_as_float(g.w & 0xffff0000u)};
        }
        { const int rn = (row + rstride < rend) ? row + rstride : row;
#pragma unroll
          for (int i = 0; i < 4; ++i) gn[i] = *(const u32x4*)(r16 + (size_t)rn * 2048 + (i * 64 + lane) * 8); }
#pragma unroll
        for (int i = 0; i < 8; ++i) s += (v[i][0] + v[i][1]) + (v[i][2] + v[i][3]);
        float mu = wave_sum(s) * (1.0f / 2048.0f);
        float q = 0.f;
#pragma unroll
        for (int i = 0; i < 8; ++i) { v[i] -= mu; q += (v[i][0] * v[i][0] + v[i][1] * v[i][1]) + (v[i][2] * v[i][2] + v[i][3] * v[i][3]); }
        float rstd = rsqrtf(wave_sum(q) * (1.0f / 2048.0f) + LN_EPS);
        s = 0.f;
#pragma unroll
        for (int i = 0; i < 8; ++i) {
            const int col = ((i >> 1) * 64 + lane) * 8 + (i & 1) * 4;
            v[i] = v[i] * rstd * *(const LAS f32x4*)(pg + col) + *(const LAS f32x4*)(pb + col);
            s += (v[i][0] + v[i][1]) + (v[i][2] + v[i][3]);
        }
#pragma unroll
        for (int i = 0; i < 4; ++i) st8_bf16(t16 + (size_t)row * 2048 + (i * 64 + lane) * 8, v[2 * i], v[2 * i + 1]);
        mu = wave_sum(s) * (1.0f / 2048.0f); q = 0.f;
#pragma unroll
        for (int i = 0; i < 8; ++i) { v[i] -= mu; q += (v[i][0] * v[i][0] + v[i][1] * v[i][1]) + (v[i][2] * v[i][2] + v[i][3] * v[i][3]); }
        rstd = rsqrtf(wave_sum(q) * (1.0f / 2048.0f) + LN_EPS);
#pragma unroll
        for (int i = 0; i < 4; ++i) {
            const int col = (i * 64 + lane) * 8;
            const f32x4 sh0 = *(const LAS f32x4*)(sh + col), sh1 = *(const LAS f32x4*)(sh + col + 4);
            const f32x4 sc0 = *(const LAS f32x4*)(sc + col), sc1 = *(const LAS f32x4*)(sc + col + 4);
            const f32x4 y0 = v[2 * i] * rstd * sc0 + sh0, y1 = v[2 * i + 1] * rstd * sc1 + sh1;
            st8_bf16(h2 + (size_t)row * 2048 + col, y0, y1);
            *(u32x2*)(h28 + (size_t)row * 2048 + col) = pk8_fp8(y0, y1);
        }
    }
    __syncthreads();
}

__device__ __forceinline__ void route_block(const Params& p, ldsp_t lds, const int t0, const int nt) {
    const float* logit = (const float*)(p.ws + O_LOGIT);
    int* rsel = (int*)(p.ws + O_RSEL); float* rw = (float*)(p.ws + O_RW); int* cnt = (int*)(p.ws + O_CNT);
    LAS float* sb = (LAS float*)lds;
    LAS int* hist = (LAS int*)(lds + 512 * 65 * 4);
    const int tid = opaque_tid();
    const bool act = tid < nt;
    const int tok = t0 + (act ? tid : 0), chunk = t0 / CHTOK;
    __syncthreads();
    if (tid < 64) hist[tid] = 0;
    LAS float* my = sb + tid * 65;
    if (act) {
#pragma unroll 4
        for (int e = 0; e < 64; e += 4) { const f32x4 l = *(const f32x4*)(logit + (size_t)tok * 64 + e);
#pragma unroll
            for (int j = 0; j < 4; ++j) my[e + j] = sigmoidf_(l[j]) + p.rbias[e + j]; }
    }
    __syncthreads();
    if (act) {
        float gs[8];
#pragma unroll
        for (int gI = 0; gI < 8; ++gI) { float m1 = -1e30f, m2 = -1e30f;
#pragma unroll
            for (int j = 0; j < 8; ++j) { const float v = my[gI * 8 + j]; if (v > m1) { m2 = m1; m1 = v; } else if (v > m2) m2 = v; }
            gs[gI] = m1 + m2; }
        unsigned gmask = 0;
#pragma unroll
        for (int r = 0; r < 4; ++r) { float best = -1e30f; int bi = 0;
#pragma unroll
            for (int gI = 0; gI < 8; ++gI) { const bool ok = !((gmask >> gI) & 1u) && gs[gI] > best; if (ok) { best = gs[gI]; bi = gI; } }
            gmask |= 1u << bi; }
        int se[8]; float sw[8]; float wsum = 0.f;
        unsigned long long taken = 0ull;
#pragma unroll
        for (int r = 0; r < 8; ++r) { float best = -1e30f; int bi = 0;
            for (int e = 0; e < 64; ++e) { const bool ok = ((gmask >> (e >> 3)) & 1u) && !((taken >> e) & 1ull); const float v = my[e]; if (ok && v > best) { best = v; bi = e; } }
            taken |= 1ull << bi; se[r] = bi; const float sc = my[bi] - p.rbias[bi]; sw[r] = sc; wsum += sc; }
        const float inv = 2.5f / wsum;
#pragma unroll
        for (int r = 0; r < 8; ++r) { rsel[(size_t)tok * 8 + r] = se[r]; rw[(size_t)tok * 8 + r] = sw[r] * inv; atomicAdd((int*)&hist[se[r]], 1); }
    }
    __syncthreads();
    if (tid < 64) atomicAdd(&cnt[chunk * 256 + tid], hist[tid]);
}
__device__ __forceinline__ void ph_route(const Params& p, ldsp_t lds) {
    for (int t0 = blockIdx.x * NTHREADS; t0 < NT; t0 += gridDim.x * NTHREADS) route_block(p, lds, t0, NTHREADS);
    __syncthreads();
}
__device__ __forceinline__ void ph_slots(const Params& p, ldsp_t lds) {
    const int* rsel = (const int*)(p.ws + O_RSEL); const float* rw = (const float*)(p.ws + O_RW); int* cnt = (int*)(p.ws + O_CNT);
    int* tstart = (int*)(p.ws + O_TSTART); int* tilee = (int*)(p.ws + O_TILEE);
    int* tokof = (int*)(p.ws + O_TOKOF); u32x2* wd = (u32x2*)(p.ws + O_WOF);
    LAS int* ts = (LAS int*)lds;
    const int tid = opaque_tid();
    __syncthreads();
    if (tid < NCHUNK) { int acc = 0; for (int e = 0; e < 64; ++e) { ts[tid * 66 + e] = acc; acc += (cnt[tid * 256 + e] + 255) >> 8; } ts[tid * 66 + 64] = acc; ts[tid * 66 + 65] = acc + CHTOK / 256; }
    __syncthreads();
    if (blockIdx.x == 0) {
        for (int i = tid; i < NCHUNK * 66; i += NTHREADS) tstart[(i / 66) * 128 + (i % 66)] = ts[i];
        for (int i = tid; i < NCHUNK * MAXTILES; i += NTHREADS) { const int c = i / MAXTILES, t = i % MAXTILES; int e = 0; for (int q = 0; q < 65; ++q) if (t >= ts[c * 66 + q]) e = q; tilee[c * MAXTILES + t] = e; }
    }
    for (int tok = blockIdx.x * NTHREADS + tid; tok < NT; tok += gridDim.x * NTHREADS) {
        const int c = tok / CHTOK, tl = tok % CHTOK;
#pragma unroll
        for (int r = 0; r < 8; ++r) {
            const int e = rsel[(size_t)tok * 8 + r];
            const int rank = atomicAdd(&cnt[c * 256 + 128 + e], 1);
            const int slot = ts[c * 66 + e] * 256 + rank;
            tokof[c * MAXSLOTS + slot] = tok; wd[c * MAXSLOTS + slot] = (u32x2){__float_as_uint(rw[(size_t)tok * 8 + r]), (unsigned)(tl * 8 + r)};
        }
        const int slot = ts[c * 66 + 64] * 256 + tl;
        tokof[c * MAXSLOTS + slot] = tok; wd[c * MAXSLOTS + slot] = (u32x2){__float_as_uint(1.0f), (unsigned)tok};
    }
    for (int i = blockIdx.x * NTHREADS + tid; i < NCHUNK * 64 * 256; i += gridDim.x * NTHREADS) {
        const int c = i >> 14, e = (i >> 8) & 63, j = i & 255;
        const int n = cnt[c * 256 + e], pad = ((n + 255) & ~255) - n;
        if (j < pad) { const int slot = ts[c * 66 + e] * 256 + n + j; tokof[c * MAXSLOTS + slot] = c * CHTOK; wd[c * MAXSLOTS + slot] = (u32x2){0u, 0xffffffffu}; }
    }
    __syncthreads();
}
__device__ __forceinline__ int exp1_units_of(int wg, int ntiles, int G) {
    if (G == 256) { const int rem = ntiles - 8 * (wg & 7) - ((wg >> 3) & 7); return rem > 0 ? (rem + 63) >> 6 : 0; }
    const int tot = ntiles * 4; return tot > wg ? (tot - wg + G - 1) / G : 0;
}
__device__ __forceinline__ void ph_combine(const Params& p, ldsp_t lds, int chunk) {
    const float* mod = (const float*)(p.ws + O_MOD); const unsigned char* Y = p.ws + O_Y; const bf16_t* t16 = (const bf16_t*)(p.ws + O_H2);
    const int tid_ = opaque_tid(); const int lane0 = tid_ & 63, wv = tid_ >> 6;
    LAS float* pg2 = (LAS float*)lds; LAS float* pg = pg2 + (CHTOK / SEQ) * 2048; LAS float* pb = pg + 2048;
    __syncthreads();
    for (int i = tid_; i < (CHTOK / SEQ) * 2048; i += NTHREADS) pg2[i] = mod[(chunk * (CHTOK / SEQ) + (i >> 11)) * 12288 + 5 * 2048 + (i & 2047)] * (1.0f / YSCALE);
    for (int i = tid_; i < 2048; i += NTHREADS) { pg[i] = p.ln2g[i]; pb[i] = p.ln2b[i]; }
    __syncthreads();
#pragma unroll 1
    for (int tl = blockIdx.x * 8 + wv; tl < CHTOK; tl += gridDim.x * 8) {
        const int row = chunk * CHTOK + tl;
        const LAS float* g2p = pg2 + (tl >> 13) * 2048;
        int lane = lane0; asm volatile("" : "+v"(lane));
        float* xr = p.out + (size_t)row * 2048;
        f32x4 a[8];
#pragma unroll
        for (int i = 0; i < 8; ++i) a[i] = (f32x4){0.f, 0.f, 0.f, 0.f};
#pragma unroll 4
        for (int j = 0; j < 8; ++j) {
            const unsigned char* yr = Y + ((size_t)tl * 8 + j) * 2048;
#pragma unroll
            for (int i = 0; i < 2; ++i) {
                const u32x4 g = *(const u32x4*)(yr + (i * 64 + lane) * 16);
#pragma unroll
                for (int qd = 0; qd < 4; ++qd) {
                    const f32x2 lo = __builtin_amdgcn_cvt_pk_f32_fp8((int)g[qd], false), hi = __builtin_amdgcn_cvt_pk_f32_fp8((int)g[qd], true);
                    a[4 * i + qd][0] += lo[0]; a[4 * i + qd][1] += lo[1]; a[4 * i + qd][2] += hi[0]; a[4 * i + qd][3] += hi[1];
                }
            }
        }
        float s = 0.f;
#pragma unroll
        for (int i = 0; i < 8; ++i) {
            const int sp = ((i >> 2) * 64 + lane) * 16;
            const int col = (sp & ~255) + ((sp & 255) >> 6) * 32 + ((sp & 63) >> 4) * 8 + ((i & 3) >> 1) * 128 + (i & 1) * 4;
            const f32x4 g2 = *(const LAS f32x4*)(g2p + col);
            const u32x2 tt = *(const u32x2*)(t16 + (size_t)row * 2048 + col);
            a[i] = (f32x4){__uint_as_float(tt.x << 16), __uint_as_float(tt.x & 0xffff0000u), __uint_as_float(tt.y << 16), __uint_as_float(tt.y & 0xffff0000u)} + g2 * a[i];
            s += (a[i][0] + a[i][1]) + (a[i][2] + a[i][3]);
        }
        const float mu = wave_sum(s) * (1.0f / 2048.0f);
        float q = 0.f;
#pragma unroll
        for (int i = 0; i < 8; ++i) { a[i] -= mu; q += (a[i][0] * a[i][0] + a[i][1] * a[i][1]) + (a[i][2] * a[i][2] + a[i][3] * a[i][3]); }
        const float rstd = rsqrtf(wave_sum(q) * (1.0f / 2048.0f) + LN_EPS);
#pragma unroll
        for (int i = 0; i < 8; ++i) {
            const int sp = ((i >> 2) * 64 + lane) * 16;
            const int col = (sp & ~255) + ((sp & 255) >> 6) * 32 + ((sp & 63) >> 4) * 8 + ((i & 3) >> 1) * 128 + (i & 1) * 4;
            *(f32x4*)(xr + col) = a[i] * rstd * *(const LAS f32x4*)(pg + col) + *(const LAS f32x4*)(pb + col);
        }
    }
    __syncthreads();
}
#ifndef PROBE
#define PROBE 0
#endif
#define REP(n) for (int rep_ = 0; rep_ < p.rep[n]; ++rep_)
#define GBAR do { xcd_barrier(bar); for (int xr_ = 0; xr_ < p.rep[1]; ++xr_) xcd_barrier(bar); } while (0)
__global__ __launch_bounds__(512, 2) void mega(Params p) {
    extern __shared__ __attribute__((aligned(16))) unsigned char shm_[];
    ldsp_t lds = (ldsp_t)shm_;
    volatile LAS unsigned* st = (volatile LAS unsigned*)(lds + LDS_BYTES - 16);
    if (threadIdx.x == 0) { st[0] = 0u; st[1] = 0u; st[2] = 0u; st[3] = 0u; }
    __syncthreads();
    XcdBarrier bar = xcd_barrier_post((unsigned*)(p.ws + O_BAR), st);
    unsigned char* ws = p.ws;
    _Pragma("unroll 1") REP(8) { ph_conv_small(p, lds); ph_mod(p, lds);
    GBAR;
    ph_lnmod(p, lds);
    GBAR; }
    _Pragma("unroll 1") REP(12) { EpiInProj<false> e; e.ws = ws; gm::gemm_phase(lds, dense<3>(ws + O_HN, 2048, ws + O_BTIN, 2048), e, 2048); }
    _Pragma("unroll 1") REP(19) { EpiInProj<true> e; e.ws = ws; gm::gemm_phase(lds, dense<32>(ws + O_H8, 1024, ws + O_BTIN8, 1024), e, 1024); }
    GBAR;
    _Pragma("unroll 1") REP(9) { ph_smallnorm(p); hg::run<1>(p, lds); }
    GBAR;
    _Pragma("unroll 1") REP(11) { EpiQ e; e.ws = ws; gm::gemm_phase(lds, dense<12>(ws + O_CQN, 512, ws + O_BTQ, 512), e, 512); }
    GBAR;
    _Pragma("unroll 1") REP(2) ph_indexer(p, lds, rep_ == 0 ? 1 : p.rep[13]);
    GBAR;
    _Pragma("unroll 1") REP(3) ph_attn(p, lds);
    _Pragma("unroll 1") REP(6) hg::run<3>(p, lds);
    GBAR;
    {
    _Pragma("unroll 1") REP(7) { EpiMergeA e; e.ws = ws; e.m1 = (bf16_t*)p.out; gm::gemm_phase(lds, dense<8>(ws + O_OLAT, 1536, ws + O_BTAB, 1536), e, 1024); }
    _Pragma("unroll 1") REP(14) { EpiMergeB e; e.ws = ws; e.m1 = (const bf16_t*)p.out; gm::gemm_phase(lds, dense<8>(ws + O_OLAT + 2048, 1536, ws + O_BTAB + 2048, 1536), e, 512); }
    GBAR;
    _Pragma("unroll 1") REP(15) { EpiWo e; e.x = p.x; e.mod = (const float*)(ws + O_MOD); e.r = (bf16_t*)(ws + O_R16); gm::gemm_phase(lds, dense<8>(ws + O_MIX, 1024, ws + O_BTO, 1024), e, 1024); }
    GBAR; }
    _Pragma("unroll 1") REP(16) ph_ln1(p, lds);
    GBAR;
    {
    _Pragma("unroll 1") REP(10) { EpiRouter e; e.logit = (float*)(ws + O_LOGIT); gm::gemm_phase(lds, dense<1>(ws + O_H2, 2048, ws + O_BTR, 2048), e, 2048); }
    const bool fused_route = gridDim.x == 256;
    if (fused_route && blockIdx.x < 128) { asm volatile("s_waitcnt vmcnt(0)" ::: "memory"); __syncthreads();
        route_block(p, lds, (((int)blockIdx.x & 7) * 16 + ((int)blockIdx.x >> 3)) * 256, 256); __syncthreads(); }
    _Pragma("unroll 1") REP(17) ph_conv_experts(p, lds);
    GBAR; }
    if (gridDim.x != 256) { ph_route(p, lds);
    GBAR; }
    ph_slots(p, lds);
    GBAR;
#pragma unroll 1
    for (int c = 0; c < NCHUNK; ++c) {
        const int ntiles = c < 4 ? ((const int*)(ws + O_TSTART))[c * 128 + 65] : 0;
        if (c < 4) { _Pragma("unroll 1") REP(4) { Exp1Sched s; s.h2 = (const char*)(ws + O_H28); s.btgu = (const char*)(ws + O_BTGU); s.tokof = (const int*)(ws + O_TOKOF) + c * MAXSLOTS; s.tilee = (const int*)(ws + O_TILEE) + c * MAXTILES;
          s.ntiles = ntiles; s.G = gridDim.x; s.c = blockIdx.x; s.lda = 1024; s.ldb = 1024;
          EpiExp1 e; e.hh = ws + O_HH; gm::gemm_phase(lds, s, e, 1024); } }
        if (c < 4) {
        GBAR;
        _Pragma("unroll 1") REP(5) { Exp2Sched s; s.hh = (const char*)(ws + O_HH); s.btd = (const char*)(ws + O_BTD); s.tilee = (const int*)(ws + O_TILEE) + c * MAXTILES;
          s.ntiles = ntiles; s.G = gridDim.x; s.c = blockIdx.x; s.lda = 256; s.ldb = 256;
          EpiExp2 e; e.y = ws + O_Y; e.wd = (const u32x2*)(ws + O_WOF) + c * MAXSLOTS; e.t16 = (const bf16_t*)(ws + O_T16); e.t16o = (bf16_t*)(ws + O_H2); e.mod = (const float*)(ws + O_MOD); gm::gemm_phase(lds, s, e, 256); }
        GBAR;
        _Pragma("unroll 1") REP(18) ph_combine(p, lds, c);
        }
    }
}

extern "C" void kernel_launch(void* const* d_in, const int* in_sizes, int n_in, void* d_out, int out_size, void* d_ws, size_t ws_size, hipStream_t stream) {
    (void)in_sizes; (void)n_in; (void)out_size; (void)ws_size;
    Params p; memset(&p, 0, sizeof(p));
    const float** f = (const float**)&p;
    for (int i = 0; i < 31; ++i) f[i] = (const float*)d_in[i];
    p.out = (float*)d_out; p.ws = (unsigned char*)d_ws;
    for (int i = 0; i < 20; ++i) p.rep[i] = 1;
    p.rep[1] = 0;
    if (PROBE > 0 && PROBE < 20) p.rep[PROBE] = 2;
    if (PROBE == 13) { p.rep[2] = 2; p.rep[13] = 0; }
    static int grid = 0;
    if (!grid) {
        int dev = 0, cus = 0, per_cu = 0;
        (void)hipGetDevice(&dev);
        (void)hipDeviceGetAttribute(&cus, hipDeviceAttributeMultiprocessorCount, dev);
        (void)hipFuncSetAttribute((const void*)mega, hipFuncAttributeMaxDynamicSharedMemorySize, LDS_BYTES);
        (void)hipOccupancyMaxActiveBlocksPerMultiprocessor(&per_cu, mega, 512, LDS_BYTES);
        if (per_cu < 1) per_cu = 1;
        grid = cus * 1;
        if (grid > 256) grid = 256;
    }
    (void)hipMemsetAsync(d_ws, 0, O_ZERO_BYTES, stream);
    hipLaunchKernelGGL(mega, dim3(grid), dim3(512), LDS_BYTES, stream, p);
}
```

```cpp
#include <hip/hip_runtime.h>
#include <stdint.h>
#include <string.h>

#ifndef PROBE
#define PROBE 0
#endif
#define LAS __attribute__((address_space(3)))
typedef unsigned short u16;
typedef unsigned short bf16_t;
typedef short bf16x8 __attribute__((ext_vector_type(8)));
typedef short s16x4 __attribute__((ext_vector_type(4)));
typedef float f32x4 __attribute__((ext_vector_type(4)));
typedef float f32x2 __attribute__((ext_vector_type(2)));
typedef unsigned u32x4 __attribute__((ext_vector_type(4)));
typedef unsigned u32x2 __attribute__((ext_vector_type(2)));
typedef unsigned char LAS* ldsp_t;

constexpr int D = 2048, NB = 4, SEQ = 8192, NT = NB * SEQ;
constexpr int IN_W = 8912, IN_WP = 8960;
constexpr int NEXP = 64, EDIM = 512, NE1 = 65;
constexpr int TOPK = 256;
constexpr float DN_ALPHA = 1.189207115002721f;
constexpr float LN_EPS = 1e-6f;
constexpr int NTHREADS = 512;
constexpr int LDS_BYTES = 160 * 1024;
constexpr int NCHUNK = 2, CHTOK = NT / NCHUNK;
constexpr int MAXTILES = NT * 8 / 256 / NCHUNK + 64 + CHTOK / 256;
constexpr int MAXSLOTS = MAXTILES * 256;
constexpr int HSEG = 8, HSEGL = SEQ / HSEG;

constexpr size_t MB = 1u << 20;
constexpr size_t al(size_t x) { return (x + 255) & ~(size_t)255; }
constexpr size_t O_BAR = 0;
constexpr size_t O_CNT = 16384;
constexpr size_t O_ZERO_BYTES = 16384 + 4096;
constexpr size_t O_MOD = O_ZERO_BYTES;
constexpr size_t O_LB = O_MOD + al((size_t)4 * 12288 * 4);
constexpr size_t O_TSTART = O_LB + 4096;
constexpr size_t O_TILEE = O_TSTART + 2048;
constexpr size_t O_BTR = al(O_TILEE + NCHUNK * MAXTILES * 4 + 4096);
constexpr size_t O_BTIN = O_BTR + (size_t)256 * 2048 * 2;
constexpr size_t O_BTIN8 = O_BTIN + (size_t)768 * 2048 * 2;
constexpr size_t O_BTQ = O_BTIN8 + (size_t)8192 * 2048;
constexpr size_t O_BTAB = O_BTQ + (size_t)3072 * 512 * 2;
constexpr size_t O_BTBB = O_BTAB + (size_t)2048 * 2048 * 2;
constexpr size_t O_BTO = O_BTBB + (size_t)2048 * 1024 * 2;
constexpr size_t O_SMALL_END = O_BTO + (size_t)2048 * 2048 * 2;
constexpr size_t O_B = al(O_SMALL_END);
constexpr size_t O_PSM = O_B;
constexpr size_t O_QB = O_PSM + (size_t)NT * 768 * 2;
constexpr size_t O_LF = O_QB + (size_t)NT * 1024 * 2;
constexpr size_t O_V = O_LF + (size_t)NT * 1024 * 2;
constexpr size_t O_G = O_V + (size_t)NT * 1024 * 2;
constexpr size_t O_SGA = O_G + (size_t)NT * 1024 * 2;
constexpr size_t O_SGB = O_SGA + (size_t)NT * 2048 * 2;
constexpr size_t O_B_END = O_SGB + (size_t)NT * 2048 * 2;
constexpr size_t O_H2 = O_BTIN;
constexpr size_t O_H28 = O_H2 + (size_t)NT * 2048 * 2;
constexpr size_t O_HH = O_H28 + (size_t)NT * 2048;
constexpr size_t O_R16 = O_HH;
constexpr size_t HH_BYTES = (size_t)MAXSLOTS * 512 > (size_t)NT * 2048 * 2 ? (size_t)MAXSLOTS * 512 : (size_t)NT * 2048 * 2;
constexpr size_t O_Y = al(O_HH + HH_BYTES);
constexpr size_t O_LOGIT = O_Y + (size_t)CHTOK * 8 * 2048;
constexpr size_t O_RSEL = O_LOGIT + (size_t)NT * 64 * 4;
constexpr size_t O_RW = O_RSEL + (size_t)NT * 8 * 4;
constexpr size_t O_TOKOF = O_RW + (size_t)NT * 8 * 4;
constexpr size_t O_WOF = O_TOKOF + (size_t)NCHUNK * MAXSLOTS * 4;
constexpr size_t O_DSTOF = O_WOF + (size_t)NCHUNK * MAXSLOTS * 4;
constexpr size_t O_BTGU = al(O_DSTOF + (size_t)NCHUNK * MAXSLOTS * 4);
constexpr size_t O_BTD = O_BTGU + (size_t)NE1 * 1024 * 2048;
constexpr size_t O_END2 = O_BTD + (size_t)NE1 * 2048 * 512;
constexpr size_t O_T16 = al(O_END2);
constexpr size_t O_END3 = O_T16 + (size_t)NT * 2048 * 2;
static_assert(O_END3 <= (size_t)1270 * 1000 * 1000, "workspace budget (MoE time)");
constexpr size_t O_A = al(O_B_END);
constexpr size_t O_HN = O_A;
constexpr size_t O_QLAT = O_A;
constexpr size_t O_MIX = O_A;
constexpr size_t O_C = O_A + (size_t)NT * 2048 * 2;
constexpr size_t O_CQN = O_C;
constexpr size_t O_KV = O_CQN + (size_t)NT * 512 * 2;
constexpr size_t O_KIDX = O_KV + (size_t)NT * 128 * 2;
constexpr size_t O_WIDX = O_KIDX + (size_t)NT * 64 * 2;
constexpr size_t O_QIDX = O_WIDX + (size_t)NT * 16 * 4;
constexpr size_t O_SEL = O_QIDX + (size_t)NT * 1024 * 2;
constexpr size_t O_OLAT = O_SEL + (size_t)NT * 256 * 2;
constexpr size_t O_OB = O_OLAT + (size_t)NT * 2048 * 2;
constexpr size_t O_HST = O_OB + (size_t)NT * 1024 * 2;
constexpr size_t O_HDEC = O_HST + (size_t)256 * 128 * 128 * 4;
constexpr size_t O_END1 = O_HDEC + (size_t)256 * 128 * 4;
constexpr size_t O_H8 = al(O_END1);
constexpr size_t O_END1B = O_H8 + (size_t)NT * 2048;
static_assert(O_END1B <= (size_t)1270 * 1000 * 1000, "workspace budget");

struct Params {
    const float *x, *c, *rpb, *lbl, *ada_w, *ada_b, *w_in, *qng, *kvng, *w_uq, *w_uk, *w_uv, *w_qidx, *ikg, *ikb, *hong,
        *w_ba, *w_bb, *w_o, *ln1g, *ln1b, *w_router, *rbias, *w_eg, *w_eu, *w_ed, *w_sg, *w_su, *w_sd, *ln2g, *ln2b;
    float* out;
    unsigned char* ws;
    int rep[20];
};

__device__ __forceinline__ float bf2f(unsigned short b) { return __uint_as_float(((unsigned)b) << 16); }
__device__ __forceinline__ unsigned short f2bf(float f) { unsigned u = __float_as_uint(f); u += 0x7FFFu + ((u >> 16) & 1u); return (unsigned short)(u >> 16); }
__device__ __forceinline__ unsigned pk_bf16(float lo, float hi) { unsigned r; asm volatile("v_cvt_pk_bf16_f32 %0, %1, %2" : "=v"(r) : "v"(lo), "v"(hi)); return r; }
__device__ __forceinline__ float sigmoidf_(float v) { return __builtin_amdgcn_rcpf(1.0f + __expf(-v)); }
__device__ __forceinline__ float siluf_(float v) { return v * __builtin_amdgcn_rcpf(1.0f + __expf(-v)); }
#define DPPF(v, ctrl) __int_as_float(__builtin_amdgcn_update_dpp(0, __float_as_int(v), ctrl, 0xf, 0xf, false))
__device__ __forceinline__ float wave_sum(float v) {
    v += DPPF(v, 0xB1); v += DPPF(v, 0x4E); v += DPPF(v, 0x141); v += DPPF(v, 0x140);
    u32x2 r = __builtin_amdgcn_permlane16_swap(__float_as_uint(v), __float_as_uint(v), false, false); v = __uint_as_float(r[0]) + __uint_as_float(r[1]);
    r = __builtin_amdgcn_permlane32_swap(__float_as_uint(v), __float_as_uint(v), false, false); v = __uint_as_float(r[0]) + __uint_as_float(r[1]);
    return v;
}
__device__ __forceinline__ int wave_sum_i(int v) {
#pragma unroll
    for (int o = 32; o >= 1; o >>= 1) v += __shfl_xor(v, o);
    return v;
}
__device__ __forceinline__ int opaque_tid() { int t = threadIdx.x; asm volatile("" : "+v"(t)); return t; }
constexpr float OSCALE = 8.0f, MSCALE = 4.0f;
__device__ __forceinline__ unsigned char f2fp8(float v) { return (unsigned char)(__builtin_amdgcn_cvt_pk_fp8_f32(v, v, 0, false) & 0xff); }
constexpr float YSCALE = 16.0f;
__device__ __forceinline__ u32x2 pk8_fp8(const f32x4& v0, const f32x4& v1) {
    int lo = 0, hi = 0;
    lo = __builtin_amdgcn_cvt_pk_fp8_f32(v0[0], v0[1], lo, false); lo = __builtin_amdgcn_cvt_pk_fp8_f32(v0[2], v0[3], lo, true);
    hi = __builtin_amdgcn_cvt_pk_fp8_f32(v1[0], v1[1], hi, false); hi = __builtin_amdgcn_cvt_pk_fp8_f32(v1[2], v1[3], hi, true);
    return (u32x2){(unsigned)lo, (unsigned)hi}; }
#define XB_TMO      128
#define XB_XCNT(j)  (256  + 64 * (j))
#define XB_XSUB(j)  (1280 + 64 * (j))
#define XB_XGEN(j)  (2304 + 64 * (j))
#define XB_TOP      3328
#define XB_TOPGEN   3392
#define XCD_BAR_WORDS 3456
#define XB_SPIN_CAP (1u << 18)

__device__ __forceinline__ unsigned xb_ld(unsigned* p)              { return __hip_atomic_load(p, __ATOMIC_RELAXED, __HIP_MEMORY_SCOPE_AGENT); }
__device__ __forceinline__ unsigned xb_add(unsigned* p, unsigned v) { return __hip_atomic_fetch_add(p, v, __ATOMIC_RELAXED, __HIP_MEMORY_SCOPE_AGENT); }
__device__ __forceinline__ unsigned xb_xcc_id() { return (unsigned)__builtin_amdgcn_s_getreg((3 << 11) | 20) & 0xFu; }
#define XB_SPIN(cond, bar) do { unsigned _sp = 0; while (cond) { __builtin_amdgcn_s_sleep(1); \
    if ((++_sp & 255u) == 0u) { if (xb_ld(&(bar)[XB_TMO])) break; if (_sp > XB_SPIN_CAP) { atomicAdd(&(bar)[XB_TMO], 1u); break; } } } } while (0)

struct XcdBarrier {
    unsigned* bar; unsigned x;
    volatile LAS unsigned* st;
};

__device__ __forceinline__ XcdBarrier xcd_barrier_post(unsigned* bar, volatile LAS unsigned* st) {
    XcdBarrier b; b.bar = bar; b.x = xb_xcc_id(); b.st = st;
    if (threadIdx.x == 0) (void)xb_add(&bar[XB_XCNT(b.x)], 1u);
    return b;
}
__device__ __forceinline__ void xcd_barrier_complete(unsigned* bar, unsigned x, unsigned& nloc, unsigned& nx) {
    const unsigned G = gridDim.x * gridDim.y * gridDim.z;
    unsigned sum, cnt, mine, sp = 0u;
    for (;;) {
        sum = 0u; cnt = 0u; mine = 0u;
#pragma unroll
        for (unsigned j = 0; j < 16; ++j) { const unsigned c = xb_ld(&bar[XB_XCNT(j)]); sum += c; cnt += (c > 0u) ? 1u : 0u; mine = (j == x) ? c : mine; }
        if (sum == G) break;
        __builtin_amdgcn_s_sleep(1);
        if ((++sp & 255u) == 0u) { if (xb_ld(&bar[XB_TMO])) break; if (sp > XB_SPIN_CAP) { atomicAdd(&bar[XB_TMO], 1u); break; } }
    }
    nloc = mine > 0u ? mine : 1u; nx = cnt > 0u ? cnt : 1u;
}

__device__ __forceinline__ void xcd_barrier(const XcdBarrier& b) {
    asm volatile("s_waitcnt vmcnt(0)" ::: "memory");
    __syncthreads();
    if (threadIdx.x == 0) {
        unsigned* bar = b.bar;
        __builtin_amdgcn_s_waitcnt(0);
        unsigned nloc = b.st[0], nx = b.st[1];
        if (nloc == 0u) { xcd_barrier_complete(bar, b.x, nloc, nx); b.st[0] = nloc; b.st[1] = nx; }
        const unsigned old = xb_add(&bar[XB_XSUB(b.x)], 1u);
        const unsigned gen = old / nloc;
        if (old + 1u == (gen + 1u) * nloc) {
            __builtin_amdgcn_fence(__ATOMIC_RELEASE, "agent");
            asm volatile("s_waitcnt vmcnt(0)" ::: "memory");
            const unsigned og = xb_add(&bar[XB_TOP], 1u);
            const unsigned tg = og / nx;
            if (og + 1u == (tg + 1u) * nx) xb_add(&bar[XB_TOPGEN], 1u);
            else XB_SPIN(xb_ld(&bar[XB_TOPGEN]) == tg, bar);
            __builtin_amdgcn_fence(__ATOMIC_ACQUIRE, "agent");
            xb_add(&bar[XB_XGEN(b.x)], 1u);
            asm volatile("s_waitcnt vmcnt(0)" ::: "memory");
        } else {
            XB_SPIN(xb_ld(&bar[XB_XGEN(b.x)]) == gen, bar);
            __builtin_amdgcn_fence(__ATOMIC_ACQUIRE, "agent");
            asm volatile("s_waitcnt vmcnt(0)" ::: "memory");
        }
    }
    __syncthreads();
}
namespace gm {
typedef int i32x4_t __attribute__((ext_vector_type(4)));
typedef int i32x8_t __attribute__((ext_vector_type(8)));
constexpr int BM = 256, BK = 64, HALF = 128, HTB = HALF * BK * 2, STAGE_BYTES = 8 * HTB;
__host__ __device__ __forceinline__ int lds_byte(int r, int c) { const int st = (r >> 4) * 2 + (c >> 5), rr = r & 15, cc = c & 31, ob = rr * 64 + cc * 2; return st * 1024 + (ob ^ (((ob >> 9) & 1) << 5)); }
__host__ __device__ __forceinline__ void stage_rc(int b, int& R, int& C) { const int st = b / 1024, sb = b % 1024, swz = sb ^ (((sb >> 9) & 1) << 5); R = (st >> 1) * 16 + swz / 64; C = (st & 1) * 32 + (swz % 64) / 2; }
__host__ __device__ __forceinline__ int perm32(int rho) { const int n = rho >> 4, i = rho & 15; return 8 * (i >> 2) + 4 * n + (i & 3); }

struct Unit { int pm, pn, e; };

template <class Epi, class Sched>
__device__ __forceinline__ void gemm_phase(ldsp_t lds, const Sched& S, const Epi& E, const int K) {
    const int tid = opaque_tid(), wid = __builtin_amdgcn_readfirstlane(tid >> 6), lane = tid & 63, wr = wid >> 2, wc = wid & 3, fr = lane & 15, fq = lane >> 4;
    const int nt = K / BK;
    int Rr[2], Cc[2];
    unsigned voffB[2], voffA[2][2], nvoffA[2][2];
#pragma unroll
    for (int i = 0; i < 2; ++i) { stage_rc(tid * 16 + i * 8192, Rr[i], Cc[i]); const int Rb = Epi::PERM ? ((Rr[i] & ~31) + perm32(Rr[i] & 31)) : Rr[i];
        voffB[i] = (unsigned)(Rb * S.ldb + Cc[i]) * 2u; }
    const size_t kstep = (size_t)(BK * 2);
    const size_t hstepB = (size_t)HALF * S.ldb * 2;
    const unsigned ldsw = (unsigned)wid * 1024u;
    const int aoff = lds_byte(wr * 64 + fr, fq * 8), boff = lds_byte(wc * 32 + fr, fq * 8);
#define G_SA(b, h) (((b) * 2 + (h)) * HTB)
#define G_SB(b, h) ((4 + (b) * 2 + (h)) * HTB)
#define G_STAGE_B(bufoff, gbase) do { _Pragma("unroll") for (int _i = 0; _i < 2; ++_i) \
        __builtin_amdgcn_global_load_lds((const unsigned*)((const char*)(gbase) + voffB[_i]), (LAS unsigned*)(lds + (bufoff) + ldsw + _i * 8192), 16, 0, 0); } while (0)
#define G_STAGE_A(bufoff, gbase, vo, h) do { _Pragma("unroll") for (int _i = 0; _i < 2; ++_i) \
        __builtin_amdgcn_global_load_lds((const unsigned*)((const char*)(gbase) + (vo)[h][_i]), (LAS unsigned*)(lds + (bufoff) + ldsw + _i * 8192), 16, 0, 0); } while (0)
#define G_LD8(base_) __builtin_shufflevector(*(const LAS i32x4_t*)(base_), *(const LAS i32x4_t*)((base_) + 1024), 0, 1, 2, 3, 4, 5, 6, 7)
#define G_LDA(dst, b, h) do { if constexpr (Epi::FP8) { _Pragma("unroll") for (int m = 0; m < 4; ++m) dst##8[m] = G_LD8(lds + G_SA(b, h) + aoff + m * 2048); } \
        else { _Pragma("unroll") for (int m = 0; m < 4; ++m) _Pragma("unroll") for (int k = 0; k < 2; ++k) dst[m][k] = *(const LAS bf16x8*)(lds + G_SA(b, h) + aoff + m * 2048 + k * 1024); } } while (0)
#define G_LDB(dst, b, h) do { if constexpr (Epi::FP8) { _Pragma("unroll") for (int n = 0; n < 2; ++n) dst##8[n] = G_LD8(lds + G_SB(b, h) + boff + n * 2048); } \
        else { _Pragma("unroll") for (int n = 0; n < 2; ++n) _Pragma("unroll") for (int k = 0; k < 2; ++k) dst[n][k] = *(const LAS bf16x8*)(lds + G_SB(b, h) + boff + n * 2048 + k * 1024); } } while (0)
#define G_MMA(ai, bj, At, Bt) do { __builtin_amdgcn_s_setprio(1); \
        if constexpr (Epi::FP8) { _Pragma("unroll") for (int m = 0; m < 4; ++m) _Pragma("unroll") for (int n = 0; n < 2; ++n) \
            asm volatile("v_mfma_scale_f32_16x16x128_f8f6f4 %0, %1, %2, %0, %3, %3 op_sel_hi:[0,0,0]" : "+v"(acc[ai][bj][m][n]) : "v"(Bt##8[n]), "v"(At##8[m]), "v"(sc_one)); } \
        else { _Pragma("unroll") for (int m = 0; m < 4; ++m) _Pragma("unroll") for (int n = 0; n < 2; ++n) _Pragma("unroll") for (int k = 0; k < 2; ++k) \
            acc[ai][bj][m][n] = __builtin_amdgcn_mfma_f32_16x16x32_bf16(Bt[n][k], At[m][k], acc[ai][bj][m][n], 0, 0, 0); } \
        __builtin_amdgcn_s_setprio(0); } while (0)
#define G_WAIT_V(n) asm volatile("s_waitcnt vmcnt(" #n ")" ::: "memory")
#define G_WAIT_L(n) asm volatile("s_waitcnt lgkmcnt(" #n ")" ::: "memory")
#define G_BAR __builtin_amdgcn_s_barrier()
#define G_SCHED __builtin_amdgcn_sched_barrier(0)
    Unit cur, nxt; int ui = 0;
    if (!S.next(0, cur)) return;
    f32x4 acc[2][2][4][2];
#pragma unroll
    for (int a = 0; a < 2; ++a)
#pragma unroll
        for (int b = 0; b < 2; ++b)
#pragma unroll
            for (int m = 0; m < 4; ++m)
#pragma unroll
                for (int n = 0; n < 2; ++n) acc[a][b][m][n] = (f32x4){0.f, 0.f, 0.f, 0.f};
    const int sc_one = 0x7f7f7f7f; (void)sc_one;
    bf16x8 At[4][2], B0[2][2], B1[2][2]; i32x8_t At8[4], B08[2], B18[2];
    const char* cA = S.a_base(cur); const char* cB = S.b_base(cur);
#pragma unroll
    for (int h = 0; h < 2; ++h)
#pragma unroll
        for (int i = 0; i < 2; ++i) {
            if constexpr (Sched::GATHER) voffA[h][i] = S.a_row_off(cur, h * HALF + Rr[i]) + (unsigned)Cc[i] * 2u;
            else voffA[h][i] = (unsigned)((h * HALF + Rr[i]) * S.lda + Cc[i]) * 2u;
            nvoffA[h][i] = voffA[h][i];
        }
    G_STAGE_B(G_SB(0, 0), cB); G_STAGE_A(G_SA(0, 0), cA, voffA, 0); G_STAGE_B(G_SB(0, 1), cB + hstepB); G_STAGE_A(G_SA(0, 1), cA, voffA, 1);
    if (wr == 1) G_BAR;
    G_WAIT_V(4); G_BAR;
    G_STAGE_B(G_SB(1, 0), cB + kstep); G_STAGE_A(G_SA(1, 0), cA + kstep, voffA, 0); G_STAGE_B(G_SB(1, 1), cB + hstepB + kstep);
    G_WAIT_V(6); G_BAR;
    for (;;) {
        const bool has_next = S.next(ui + 1, nxt);
        const char* nA = has_next ? S.a_base(nxt) : cA; const char* nB = has_next ? S.b_base(nxt) : cB;
        if constexpr (Sched::GATHER) {
            if (has_next) {
#pragma unroll
                for (int h = 0; h < 2; ++h)
#pragma unroll
                    for (int i = 0; i < 2; ++i) nvoffA[h][i] = S.a_row_off(nxt, h * HALF + Rr[i]) + (unsigned)Cc[i] * 2u;
            }
        }
#define G_ACC_FENCE \
        if constexpr (Epi::FP8) { \
            asm volatile("s_nop 15\n\ts_nop 15" : "+v"(acc[0][0][0][0]), "+v"(acc[0][0][0][1]), "+v"(acc[0][0][1][0]), "+v"(acc[0][0][1][1]), "+v"(acc[0][0][2][0]), "+v"(acc[0][0][2][1]), "+v"(acc[0][0][3][0]), "+v"(acc[0][0][3][1]), \
                                                 "+v"(acc[0][1][0][0]), "+v"(acc[0][1][0][1]), "+v"(acc[0][1][1][0]), "+v"(acc[0][1][1][1]), "+v"(acc[0][1][2][0]), "+v"(acc[0][1][2][1]), "+v"(acc[0][1][3][0]), "+v"(acc[0][1][3][1])); \
            asm volatile("" : "+v"(acc[1][0][0][0]), "+v"(acc[1][0][0][1]), "+v"(acc[1][0][1][0]), "+v"(acc[1][0][1][1]), "+v"(acc[1][0][2][0]), "+v"(acc[1][0][2][1]), "+v"(acc[1][0][3][0]), "+v"(acc[1][0][3][1]), \
                             "+v"(acc[1][1][0][0]), "+v"(acc[1][1][0][1]), "+v"(acc[1][1][1][0]), "+v"(acc[1][1][1][1]), "+v"(acc[1][1][2][0]), "+v"(acc[1][1][2][1]), "+v"(acc[1][1][3][0]), "+v"(acc[1][1][3][1])); \
        }
#define G_KLOOP(tb_, te_) \
        for (int t = tb_; t < te_; t += 2) { \
            const bool last = (t == nt - 2); \
            const char* a1 = cA + (size_t)(t + 1) * kstep; \
            const char* a2 = last ? nA : cA + (size_t)(t + 2) * kstep; const char* b2 = last ? nB : cB + (size_t)(t + 2) * kstep; \
            const char* a3 = a2 + kstep; const char* b3 = b2 + kstep; \
            unsigned vo2[2][2]; \
_Pragma("unroll") \
            for (int h = 0; h < 2; ++h) \
_Pragma("unroll") \
                for (int i = 0; i < 2; ++i) vo2[h][i] = (Sched::GATHER && last) ? nvoffA[h][i] : voffA[h][i]; \
            G_LDB(B0, 0, 0); G_SCHED; G_LDA(At, 0, 0); G_STAGE_A(G_SA(1, 1), a1, voffA, 1); \
            G_WAIT_L(8); G_BAR; G_WAIT_L(0); G_MMA(0, 0, At, B0); G_BAR; G_SCHED; \
            G_LDB(B1, 0, 1); G_STAGE_B(G_SB(0, 0), b2); \
            G_BAR; G_WAIT_L(0); G_MMA(0, 1, At, B1); G_BAR; \
            G_LDA(At, 0, 1); G_STAGE_A(G_SA(0, 0), a2, vo2, 0); \
            G_BAR; G_WAIT_L(0); G_MMA(1, 0, At, B0); G_BAR; G_SCHED; \
            G_STAGE_B(G_SB(0, 1), b2 + hstepB); \
            G_WAIT_V(6); G_BAR; G_MMA(1, 1, At, B1); G_BAR; \
            G_LDB(B0, 1, 0); G_SCHED; G_LDA(At, 1, 0); G_STAGE_A(G_SA(0, 1), a2, vo2, 1); \
            G_WAIT_L(8); G_BAR; G_WAIT_L(0); G_MMA(0, 0, At, B0); G_BAR; G_SCHED; \
            G_LDB(B1, 1, 1); G_STAGE_B(G_SB(1, 0), b3); \
            G_BAR; G_WAIT_L(0); G_MMA(0, 1, At, B1); G_BAR; \
            G_LDA(At, 1, 1); G_STAGE_A(G_SA(1, 0), a3, vo2, 0); \
            G_BAR; G_WAIT_L(0); G_MMA(1, 0, At, B0); G_BAR; G_SCHED; \
            G_STAGE_B(G_SB(1, 1), b3 + hstepB); \
            G_WAIT_V(6); G_BAR; G_MMA(1, 1, At, B1); G_BAR; \
        }
        if constexpr (Epi::MID_T >= 0) { G_KLOOP(0, Epi::MID_T) G_ACC_FENCE E.mid(acc, cur, wr, wc, fr, fq); G_KLOOP(Epi::MID_T, nt) }
        else { G_KLOOP(0, nt) }
#undef G_KLOOP
        G_ACC_FENCE
        E(acc, cur, wr, wc, fr, fq);
        if (!has_next) break;
#pragma unroll
        for (int a = 0; a < 2; ++a)
#pragma unroll
            for (int b = 0; b < 2; ++b)
#pragma unroll
                for (int m = 0; m < 4; ++m)
#pragma unroll
                    for (int n = 0; n < 2; ++n) acc[a][b][m][n] = (f32x4){0.f, 0.f, 0.f, 0.f};
        cur = nxt; cA = nA; cB = nB; ++ui;
        if constexpr (Sched::GATHER) {
#pragma unroll
            for (int h = 0; h < 2; ++h)
#pragma unroll
                for (int i = 0; i < 2; ++i) voffA[h][i] = nvoffA[h][i];
        }
    }
    G_WAIT_V(0);
    if (wr == 0) G_BAR;
    G_BAR;
#undef G_SA
#undef G_SB
#undef G_STAGE_A
#undef G_STAGE_B
#undef G_ACC_FENCE
#undef G_LD8
#undef G_LDA
#undef G_LDB
#undef G_MMA
#undef G_WAIT_V
#undef G_WAIT_L
#undef G_BAR
#undef G_SCHED
}

template <int NN>
struct DenseSchedT {
    static constexpr bool GATHER = false;
    const char* A; const char* Bt; int lda, ldb, G, c;
    __device__ __forceinline__ bool next(int i, Unit& u) const {
        constexpr int nwg = 128 * NN, q = nwg / 8, nig = 8 * NN;
        const int L = i * G + c; if (L >= nwg) return false;
        const int wgid = (L & 7) * q + (L >> 3);
        const int gid = wgid / nig, rem = wgid - gid * nig;
        u.pm = gid * 8 + (rem & 7); u.pn = rem >> 3; u.e = 0; return true;
    }
    __device__ __forceinline__ const char* a_base(const Unit& u) const { return A + (size_t)u.pm * 256 * lda * 2; }
    __device__ __forceinline__ unsigned a_row_off(const Unit&, int) const { return 0u; }
    __device__ __forceinline__ const char* b_base(const Unit& u) const { return Bt + (size_t)u.pn * 256 * ldb * 2; }
};
}
__device__ __forceinline__ int conv_row(int n, int mode) {
    if (mode == 0) return n;
    if (mode == 1) return n < 720 ? n : n + 48;
    return (n >> 7) * 256 + (n & 127) + (mode == 3 ? 128 : 0);
}
__device__ __forceinline__ void conv_job(ldsp_t lds, const float* src, int ld_src, int K, int N, bf16_t* dst, int ld_dst, int mode, int nbatch, size_t sb, size_t db) {
    LAS float* tile = (LAS float*)lds;
    const int tid = opaque_tid(), tk = K / 128, tn = (N + 127) / 128, per = tk * tn, total = per * nbatch;
    for (int t = blockIdx.x; t < total; t += gridDim.x) {
        const int bi = t / per, tt = t % per, k0 = (tt / tn) * 128, n0 = (tt % tn) * 128;
        const float* s = src + (size_t)bi * sb; bf16_t* d = dst + (size_t)bi * db;
        const int r = tid >> 5, c4 = (tid & 31) * 4;
        f32x4 v[8];
#pragma unroll
        for (int ps = 0; ps < 8; ++ps) { v[ps] = (f32x4){0.f, 0.f, 0.f, 0.f}; if (n0 + c4 < N) v[ps] = *(const f32x4*)(s + (size_t)(k0 + r + 16 * ps) * ld_src + n0 + c4); }
        __syncthreads();
#pragma unroll
        for (int ps = 0; ps < 8; ++ps) { const int k = r + 16 * ps; tile[k * 129 + c4 + 0] = v[ps][0]; tile[k * 129 + c4 + 1] = v[ps][1]; tile[k * 129 + c4 + 2] = v[ps][2]; tile[k * 129 + c4 + 3] = v[ps][3]; }
        __syncthreads();
        const int nn = tid >> 2, kq = tid & 3;
        if (n0 + nn < N) {
            bf16_t* drow = d + (size_t)conv_row(n0 + nn, mode) * ld_dst + k0;
#pragma unroll
            for (int ps = 0; ps < 4; ++ps) {
                const int k8 = (kq + 4 * ps) * 8;
                float f[8];
#pragma unroll
                for (int j = 0; j < 8; ++j) f[j] = tile[(k8 + j) * 129 + nn];
                u32x4 w; w.x = pk_bf16(f[0], f[1]); w.y = pk_bf16(f[2], f[3]); w.z = pk_bf16(f[4], f[5]); w.w = pk_bf16(f[6], f[7]);
                *(u32x4*)(drow + k8) = w;
            }
        }
    }
    __syncthreads();
}
__device__ __forceinline__ void conv_job8(ldsp_t lds, const float* src, int ld_src, int K, int N, unsigned char* dst, int ld_dst, int mode, int nbatch, size_t sb, size_t db, bool kperm = false) {
    const int tid = opaque_tid(), wv = __builtin_amdgcn_readfirstlane(tid >> 6), lane = tid & 63;
    const int tk = K / 128, tn = N / 128, per = tk * tn, total = per * nbatch, G = gridDim.x;
    const int hl = lane >> 5, slot = lane & 31;
    const int kb = tid & 15, nblk = tid >> 4;
    auto issue = [&](int t, int buf) {
        const int bi = t / per, tt = t % per, k0 = (tt / tn) * 128, n0 = (tt % tn) * 128;
        const float* s = src + (size_t)bi * sb + (size_t)k0 * ld_src + n0;
#pragma unroll
        for (int i = 0; i < 8; ++i) { const int row = (wv * 8 + i) * 2 + hl, piece = slot ^ ((row >> 3) & 15);
            __builtin_amdgcn_global_load_lds((const unsigned*)(s + (size_t)row * ld_src + piece * 4), (LAS unsigned*)(lds + buf * 65536 + (wv * 8 + i) * 1024), 16, 0, 0); }
    };
    int t = blockIdx.x, buf = 0;
    __syncthreads();
    if (t < total) issue(t, 0);
#pragma unroll 1
    for (; t < total; t += G, buf ^= 1) {
        if (t + G < total) { issue(t + G, buf ^ 1); asm volatile("s_waitcnt vmcnt(8)" ::: "memory"); } else asm volatile("s_waitcnt vmcnt(0)" ::: "memory");
        __syncthreads();
        const int bi = t / per, tt = t % per, k0 = (tt / tn) * 128, n0 = (tt % tn) * 128;
        f32x4 f[8];
#pragma unroll
        for (int j = 0; j < 8; ++j) f[j] = *(LAS const f32x4*)(lds + buf * 65536 + (kb * 8 + j) * 512 + ((nblk ^ kb) * 16));
        const int k8 = k0 + kb * 8;
        unsigned char* d = dst + (size_t)bi * db + (kperm ? (k8 & ~255) + ((k8 >> 5) & 3) * 64 + ((k8 >> 3) & 3) * 16 + ((k8 >> 7) & 1) * 8 : k8);
#pragma unroll
        for (int c = 0; c < 4; ++c) {
            const u32x2 w = pk8_fp8((f32x4){f[0][c], f[1][c], f[2][c], f[3][c]} * 64.0f, (f32x4){f[4][c], f[5][c], f[6][c], f[7][c]} * 64.0f);
            *(u32x2*)(d + (size_t)conv_row(n0 + nblk * 4 + c, mode) * ld_dst) = w;
        }
        __syncthreads();
    }
}
__device__ __forceinline__ void zero_fill16(unsigned char* dst, size_t bytes) {
    const size_t n = bytes / 16;
    for (size_t i = (size_t)blockIdx.x * NTHREADS + opaque_tid(); i < n; i += (size_t)gridDim.x * NTHREADS) ((u32x4*)dst)[i] = (u32x4){0u, 0u, 0u, 0u};
}

__device__ __forceinline__ void ph_conv_small(const Params& p, ldsp_t lds) {
    unsigned char* ws = p.ws;
    bf16_t* btin = (bf16_t*)(ws + O_BTIN); bf16_t* btq = (bf16_t*)(ws + O_BTQ); bf16_t* btab = (bf16_t*)(ws + O_BTAB);
    bf16_t* btbb = (bf16_t*)(ws + O_BTBB); bf16_t* bto = (bf16_t*)(ws + O_BTO); bf16_t* btr = (bf16_t*)(ws + O_BTR);
    const int tid = opaque_tid();
    conv_job(lds, p.w_in, IN_W, 2048, 720, btin, 2048, 0, 1, 0, 0);
    conv_job8(lds, p.w_in + 720, IN_W, 2048, 8192, ws + O_BTIN8, 2048, 0, 1, 0, 0);
    conv_job(lds, p.w_qidx, 1024, 512, 1024, btq + (size_t)2048 * 512, 512, 0, 1, 0, 0);
    conv_job8(lds, p.w_bb, 2048, 1024, 2048, (unsigned char*)btab + 2048, 3072, 0, 1, 0, 0);
    conv_job8(lds, p.w_o, 2048, 2048, 2048, (unsigned char*)bto, 2048, 0, 1, 0, 0, true);
    conv_job(lds, p.w_router, 64, 2048, 64, btr, 2048, 0, 1, 0, 0);
    zero_fill16((unsigned char*)(btin + (size_t)720 * 2048), (size_t)48 * 2048 * 2);
    zero_fill16((unsigned char*)(btr + (size_t)64 * 2048), (size_t)192 * 2048 * 2);
    if (blockIdx.x == 0) for (int i = tid; i < 1024; i += NTHREADS) { const float a = p.lbl[i], b = p.lbl[1024 + i]; ((float*)(ws + O_LB))[i] = 1.0f / (1.0f + __expf(b - a)); }
    for (int u = blockIdx.x; u < 256; u += gridDim.x) {
        const int n0 = u * 8, h = n0 >> 7, c0 = n0 & 127, r = tid;
        float sacc[8];
#pragma unroll
        for (int ci = 0; ci < 8; ++ci) sacc[ci] = 0.f;
#pragma unroll 2
        for (int d4 = 0; d4 < 32; ++d4) {
            const f32x4 v = *(const f32x4*)(p.w_uq + (size_t)r * 2048 + h * 128 + d4 * 4);
#pragma unroll
            for (int ci = 0; ci < 8; ++ci) { const f32x4 k4 = *(const f32x4*)(p.w_uk + ((size_t)h * 128 + c0 + ci) * 128 + d4 * 4);
                sacc[ci] += (v[0] * k4[0] + v[1] * k4[1]) + (v[2] * k4[2] + v[3] * k4[3]); }
        }
#pragma unroll
        for (int ci = 0; ci < 8; ++ci) btq[(size_t)(n0 + ci) * 512 + r] = f2bf(sacc[ci]);
    }
    for (int u = blockIdx.x; u < 256; u += gridDim.x) {
        const int h = u >> 4, nb = u & 15;
        LAS float* tb = (LAS float*)lds;
        __syncthreads();
        for (int i = tid; i < 64 * 32; i += NTHREADS) { const int v = i >> 5, n4 = (i & 31) * 4; const f32x4 x = *(const f32x4*)(p.w_ba + (size_t)(h * 64 + v) * 2048 + nb * 128 + n4);
            tb[v * 128 + n4] = x[0]; tb[v * 128 + n4 + 1] = x[1]; tb[v * 128 + n4 + 2] = x[2]; tb[v * 128 + n4 + 3] = x[3]; }
        __syncthreads();
        const int c = tid & 127, nq = tid >> 7;
        float aacc[32];
#pragma unroll
        for (int i = 0; i < 32; ++i) aacc[i] = 0.f;
#pragma unroll 1
        for (int v = 0; v < 64; ++v) {
            const float uvv = p.w_uv[((size_t)h * 128 + c) * 64 + v];
#pragma unroll
            for (int i4 = 0; i4 < 8; ++i4) { const f32x4 t4 = *(const LAS f32x4*)(tb + v * 128 + nq * 32 + i4 * 4);
                aacc[i4 * 4] += uvv * t4[0]; aacc[i4 * 4 + 1] += uvv * t4[1]; aacc[i4 * 4 + 2] += uvv * t4[2]; aacc[i4 * 4 + 3] += uvv * t4[3]; }
        }
        const int cp = ((c >> 2) & 3) * 32 + (c >> 4) * 4 + (c & 3);
#pragma unroll
        for (int i = 0; i < 32; ++i) ((unsigned char*)btab)[(size_t)(nb * 128 + nq * 32 + i) * 3072 + h * 128 + cp] = f2fp8(aacc[i] * 64.0f);
    }
    __syncthreads();
}

__device__ __forceinline__ void ph_conv_experts(const Params& p, ldsp_t lds) {
    unsigned char* btgu = p.ws + O_BTGU; unsigned char* btd = p.ws + O_BTD;
    conv_job8(lds, p.w_eg, 512, 2048, 512, btgu, 2048, 2, 64, (size_t)2048 * 512, (size_t)1024 * 2048);
    conv_job8(lds, p.w_eu, 512, 2048, 512, btgu, 2048, 3, 64, (size_t)2048 * 512, (size_t)1024 * 2048);
    conv_job8(lds, p.w_ed, 2048, 512, 2048, btd, 512, 0, 64, (size_t)512 * 2048, (size_t)2048 * 512);
    conv_job8(lds, p.w_sg, 512, 2048, 512, btgu + (size_t)64 * 1024 * 2048, 2048, 2, 1, 0, 0);
    conv_job8(lds, p.w_su, 512, 2048, 512, btgu + (size_t)64 * 1024 * 2048, 2048, 3, 1, 0, 0);
    conv_job8(lds, p.w_sd, 2048, 512, 2048, btd + (size_t)64 * 2048 * 512, 512, 0, 1, 0, 0);
}

__device__ __forceinline__ void ph_mod(const Params& p, ldsp_t lds) {
    LAS float* cond = (LAS float*)lds;
    LAS float* red = (LAS float*)(lds + 32768);
    float* mod = (float*)(p.ws + O_MOD);
    const int tid = opaque_tid();
    for (int w = blockIdx.x; w < 256; w += gridDim.x) {
        __syncthreads();
        for (int i = tid; i < 4 * 2048; i += NTHREADS) cond[i] = siluf_(p.c[i]);
        __syncthreads();
        if (tid < 384) {
            const int cq = tid % 12, kl = tid / 12;
            float a[4][4];
#pragma unroll
            for (int b = 0; b < 4; ++b)
#pragma unroll
                for (int j = 0; j < 4; ++j) a[b][j] = 0.f;
#pragma unroll 1
            for (int k0 = kl; k0 < 2048; k0 += 256) {
                f32x4 wv[8];
#pragma unroll
                for (int u8 = 0; u8 < 8; ++u8) wv[u8] = *(const f32x4*)(p.ada_w + (size_t)(k0 + 32 * u8) * 12288 + w * 48 + cq * 4);
#pragma unroll
                for (int u8 = 0; u8 < 8; ++u8) { const int k = k0 + 32 * u8;
#pragma unroll
                    for (int b = 0; b < 4; ++b) { const float cb = cond[b * 2048 + k];
#pragma unroll
                        for (int j = 0; j < 4; ++j) a[b][j] += cb * wv[u8][j]; } }
            }
#pragma unroll
            for (int b = 0; b < 4; ++b)
#pragma unroll
                for (int j = 0; j < 4; ++j) red[(kl * 12 + cq) * 16 + b * 4 + j] = a[b][j];
        }
        __syncthreads();
        if (tid < 192) {
            const int cq = tid / 16, bj = tid % 16, b = bj >> 2, j = bj & 3;
            float s = 0.f;
            for (int kl = 0; kl < 32; ++kl) s += red[(kl * 12 + cq) * 16 + bj];
            const int n = w * 48 + cq * 4 + j;
            mod[b * 12288 + n] = s + p.ada_b[n];
        }
    }
    __syncthreads();
}

__device__ __forceinline__ void ph_lnmod(const Params& p, ldsp_t lds) {
    const float* mod = (const float*)(p.ws + O_MOD);
    bf16_t* hn = (bf16_t*)(p.ws + O_HN); unsigned char* h8 = p.ws + O_H8;
    const int tid_ = opaque_tid(); const int lane = tid_ & 63, wv = tid_ >> 6;
    const bool bmap = gridDim.x == 256;
    const int row0 = bmap ? ((int)(blockIdx.x & 3) * SEQ + (int)(blockIdx.x >> 2) * 8 + wv) : (int)blockIdx.x * 8 + wv;
    const int rstride = bmap ? 512 : (int)gridDim.x * 8, rend = bmap ? ((int)(blockIdx.x & 3) + 1) * SEQ : NT;
    LAS float* psh = (LAS float*)lds;
    __syncthreads();
    if (bmap) { const int b = blockIdx.x & 3; for (int i = tid_; i < 2048; i += NTHREADS) { psh[i] = mod[b * 12288 + i]; psh[2048 + i] = mod[b * 12288 + 2048 + i] + 1.0f; } }
    else { for (int i = tid_; i < 4 * 2048; i += NTHREADS) { const int b = i >> 11, c = i & 2047; psh[b * 4096 + c] = mod[b * 12288 + c]; psh[b * 4096 + 2048 + c] = mod[b * 12288 + 2048 + c] + 1.0f; } }
    __syncthreads();
#pragma unroll 1
    for (int row = row0; row < rend; row += rstride) {
        const LAS float* sh = bmap ? psh : psh + (row >> 13) * 4096;
        const float* xr = p.x + (size_t)row * 2048;
        f32x4 v[8]; float s = 0.f;
#pragma unroll
        for (int i = 0; i < 8; ++i) { v[i] = *(const f32x4*)(xr + (i * 64 + lane) * 4); s += (v[i][0] + v[i][1]) + (v[i][2] + v[i][3]); }
        const float mu = wave_sum(s) * (1.0f / 2048.0f);
        float q = 0.f;
#pragma unroll
        for (int i = 0; i < 8; ++i) { v[i] -= mu; q += (v[i][0] * v[i][0] + v[i][1] * v[i][1]) + (v[i][2] * v[i][2] + v[i][3] * v[i][3]); }
        const float rstd = rsqrtf(wave_sum(q) * (1.0f / 2048.0f) + LN_EPS);
#pragma unroll
        for (int i = 0; i < 8; ++i) {
            const int col = (i * 64 + lane) * 4;
            const f32x4 y = v[i] * rstd * *(const LAS f32x4*)(sh + 2048 + col) + *(const LAS f32x4*)(sh + col);
            u32x2 w; w.x = pk_bf16(y[0], y[1]); w.y = pk_bf16(y[2], y[3]);
            *(u32x2*)(hn + (size_t)row * 2048 + col) = w;
            { int q8 = 0; q8 = __builtin_amdgcn_cvt_pk_fp8_f32(y[0], y[1], q8, false); q8 = __builtin_amdgcn_cvt_pk_fp8_f32(y[2], y[3], q8, true); *(int*)(h8 + (size_t)row * 2048 + col) = q8; }
        }
    }
    __syncthreads();
}
using gm::Unit;
__device__ __forceinline__ unsigned pk_f16(float lo, float hi) { const _Float16 a = (_Float16)lo, b = (_Float16)hi; return (unsigned)__builtin_bit_cast(unsigned short, a) | ((unsigned)__builtin_bit_cast(unsigned short, b) << 16); }
__device__ __forceinline__ void st8_bf16(bf16_t* dst, const f32x4& v0, const f32x4& v1) {
    u32x4 w; w.x = pk_bf16(v0[0], v0[1]); w.y = pk_bf16(v0[2], v0[3]); w.z = pk_bf16(v1[0], v1[1]); w.w = pk_bf16(v1[2], v1[3]); *(u32x4*)dst = w; }

template <bool F8>
struct EpiInProj {
    static constexpr bool PERM = true; static constexpr int MID_T = -1; static constexpr bool FP8 = F8;
    unsigned char* ws;
    __device__ __forceinline__ void operator()(const f32x4 (&acc)[2][2][4][2], const Unit& u, int wr, int wc, int fr, int fq) const {
        const int pn = u.pn + (F8 ? 3 : 0); const int row0 = u.pm * 256 + wr * 64 + fr;
        const float* lb = (const float*)(ws + O_LB);
        int type, cbase, ldo; bf16_t* base;
        if (pn < 3) { type = 0; base = (bf16_t*)(ws + O_PSM); cbase = pn * 256; ldo = 768; }
        else if (pn < 7) { type = 1; base = (bf16_t*)(ws + O_QB); cbase = (pn - 3) * 256; ldo = 1024; }
        else if (pn < 11) { type = 2; base = (bf16_t*)(ws + O_LF); cbase = (pn - 7) * 256; ldo = 1024; }
        else if (pn < 15) { type = 0; base = (bf16_t*)(ws + O_V); cbase = (pn - 11) * 256; ldo = 1024; }
        else if (pn < 19) { type = 3; base = (bf16_t*)(ws + O_G); cbase = (pn - 15) * 256; ldo = 1024; }
        else if (pn < 27) { type = 4; base = (bf16_t*)(ws + O_SGA); cbase = (pn - 19) * 256; ldo = 2048; }
        else { type = 4; base = (bf16_t*)(ws + O_SGB); cbase = (pn - 27) * 256; ldo = 2048; }
        if (type == 4) {
#pragma unroll
            for (int ai = 0; ai < 2; ++ai)
#pragma unroll
                for (int m = 0; m < 4; ++m) {
                    const int row = row0 + ai * 128 + m * 16;
                    unsigned w[4] = {0u, 0u, 0u, 0u};
#pragma unroll
                    for (int bj = 0; bj < 2; ++bj)
#pragma unroll
                        for (int j = 0; j < 4; ++j) { w[2 * bj] |= (unsigned)(sigmoidf_(acc[ai][bj][m][0][j] * (1.0f / 64.0f)) * 255.0f + 0.5f) << (8 * j); w[2 * bj + 1] |= (unsigned)(sigmoidf_(acc[ai][bj][m][1][j] * (1.0f / 64.0f)) * 255.0f + 0.5f) << (8 * j); }
                    *(u32x4*)((unsigned char*)base + (size_t)row * 2048 + cbase + wc * 64 + fq * 16) = (u32x4){w[0], w[1], w[2], w[3]};
                }
            return;
        }
#pragma unroll
        for (int bj = 0; bj < 2; ++bj) {
            const int col = cbase + bj * 128 + wc * 32 + 8 * fq;
            f32x4 l0 = (f32x4){0.f, 0.f, 0.f, 0.f}, l1 = l0;
            if (type == 2) { l0 = *(const f32x4*)(lb + col); l1 = *(const f32x4*)(lb + col + 4); }
#pragma unroll
            for (int ai = 0; ai < 2; ++ai)
#pragma unroll
                for (int m = 0; m < 4; ++m) {
                    const int row = row0 + ai * 128 + m * 16;
                    f32x4 v0 = acc[ai][bj][m][0], v1 = acc[ai][bj][m][1];
                    if (F8) { v0 *= (1.0f / 64.0f); v1 *= (1.0f / 64.0f); }
                    bf16_t* dst = base + (size_t)row * ldo + col;
                    if (type == 2) {
                        float f[8];
#pragma unroll
                        for (int j = 0; j < 4; ++j) { f[j] = __logf(l0[j] + (1.0f - l0[j]) * sigmoidf_(v0[j])); f[4 + j] = __logf(l1[j] + (1.0f - l1[j]) * sigmoidf_(v1[j])); }
                        u32x4 w; w.x = pk_f16(f[0], f[1]); w.y = pk_f16(f[2], f[3]); w.z = pk_f16(f[4], f[5]); w.w = pk_f16(f[6], f[7]);
                        *(u32x4*)dst = w;
                    } else {
                        if (type == 1) {
#pragma unroll
                            for (int j = 0; j < 4; ++j) { v0[j] = siluf_(v0[j]) * 0.08838834764831845f; v1[j] = siluf_(v1[j]) * 0.08838834764831845f; }
                        } else if (type == 3) {
#pragma unroll
                            for (int j = 0; j < 4; ++j) { v0[j] = siluf_(v0[j]); v1[j] = siluf_(v1[j]); }
                        }
                        st8_bf16(dst, v0, v1);
                    }
                }
        }
    }
};
struct EpiQ {
    static constexpr bool PERM = true; static constexpr int MID_T = -1; static constexpr bool FP8 = false;
    unsigned char* ws;
    __device__ __forceinline__ void operator()(const f32x4 (&acc)[2][2][4][2], const Unit& u, int wr, int wc, int fr, int fq) const {
        const int pn = u.pn; const int row0 = u.pm * 256 + wr * 64 + fr;
        const bool lat = pn < 8;
        bf16_t* base = (bf16_t*)(ws + (lat ? O_QLAT : O_QIDX)); const int ldo = lat ? 2048 : 1024, cbase = (lat ? pn : pn - 8) * 256; const float sc = lat ? 0.08838834764831845f : 1.0f;
#pragma unroll
        for (int ai = 0; ai < 2; ++ai)
#pragma unroll
            for (int m = 0; m < 4; ++m)
#pragma unroll
                for (int bj = 0; bj < 2; ++bj) {
                    const int row = row0 + ai * 128 + m * 16, col = cbase + bj * 128 + wc * 32 + 8 * fq;
                    st8_bf16(base + (size_t)row * ldo + col, acc[ai][bj][m][0] * sc, acc[ai][bj][m][1] * sc);
                }
    }
};
__device__ __forceinline__ void unpack8(const u32x4& g, float (&f)[8]) {
    f[0] = __uint_as_float(g.x << 16); f[1] = __uint_as_float(g.x & 0xffff0000u); f[2] = __uint_as_float(g.y << 16); f[3] = __uint_as_float(g.y & 0xffff0000u);
    f[4] = __uint_as_float(g.z << 16); f[5] = __uint_as_float(g.z & 0xffff0000u); f[6] = __uint_as_float(g.w << 16); f[7] = __uint_as_float(g.w & 0xffff0000u); }
__device__ __forceinline__ void unpack8u(const u32x2& g, float (&f)[8]) {
    f[0] = (float)((g.x >> 0) & 0xffu); f[1] = (float)((g.x >> 8) & 0xffu); f[2] = (float)((g.x >> 16) & 0xffu); f[3] = (float)((g.x >> 24) & 0xffu);
    f[4] = (float)((g.y >> 0) & 0xffu); f[5] = (float)((g.y >> 8) & 0xffu); f[6] = (float)((g.y >> 16) & 0xffu); f[7] = (float)((g.y >> 24) & 0xffu); }
struct EpiMergeA {
    static constexpr bool PERM = true; static constexpr int MID_T = -1; static constexpr bool FP8 = true;
    unsigned char* ws; bf16_t* m1;
    __device__ __forceinline__ void operator()(const f32x4 (&acc)[2][2][4][2], const Unit& u, int wr, int wc, int fr, int fq) const {
        const int row0 = u.pm * 256 + wr * 64 + fr; const unsigned char* __restrict__ sg = ws + O_SGA;
        const int colb = u.pn * 256 + wc * 32 + 8 * fq;
#pragma unroll
        for (int ai = 0; ai < 2; ++ai) {
            u32x2 g[4][2];
#pragma unroll
            for (int m = 0; m < 4; ++m) { const u32x4 gq = *(const u32x4*)(sg + (size_t)(row0 + ai * 128 + m * 16) * 2048 + u.pn * 256 + wc * 64 + fq * 16);
                g[m][0] = (u32x2){gq.x, gq.y}; g[m][1] = (u32x2){gq.z, gq.w}; }
#pragma unroll
            for (int m = 0; m < 4; ++m)
#pragma unroll
                for (int bj = 0; bj < 2; ++bj) {
                    float f[8]; unpack8u(g[m][bj], f);
                    f32x4 o0, o1;
#pragma unroll
                    for (int j = 0; j < 4; ++j) { o0[j] = f[j] * acc[ai][bj][m][0][j] * (1.0f / (255.0f * 64.0f * OSCALE)); o1[j] = f[4 + j] * acc[ai][bj][m][1][j] * (1.0f / (255.0f * 64.0f * OSCALE)); }
                    st8_bf16(m1 + (size_t)(row0 + ai * 128 + m * 16) * 2048 + colb + bj * 128, o0, o1);
                }
        }
    }
};
struct EpiMergeB {
    static constexpr bool PERM = true; static constexpr int MID_T = -1; static constexpr bool FP8 = true;
    unsigned char* ws; const bf16_t* m1;
    __device__ __forceinline__ void operator()(const f32x4 (&acc)[2][2][4][2], const Unit& u, int wr, int wc, int fr, int fq) const {
        const int row0 = u.pm * 256 + wr * 64 + fr; const unsigned char* __restrict__ sg = ws + O_SGB; unsigned char* mix = ws + O_MIX;
        const int colb = u.pn * 256 + wc * 32 + 8 * fq, pos = u.pn * 256 + wc * 64 + fq * 16;
#pragma unroll
        for (int ai = 0; ai < 2; ++ai)
#pragma unroll
            for (int mh = 0; mh < 2; ++mh) {
                u32x4 g[2], a[2][2];
#pragma unroll
                for (int mm = 0; mm < 2; ++mm) { const size_t ro = (size_t)(row0 + ai * 128 + (2 * mh + mm) * 16) * 2048; g[mm] = *(const u32x4*)(sg + ro + pos);
                    a[mm][0] = *(const u32x4*)(m1 + ro + colb); a[mm][1] = *(const u32x4*)(m1 + ro + colb + 128); }
#pragma unroll
                for (int mm = 0; mm < 2; ++mm) { const int m = 2 * mh + mm;
                    u32x2 w8[2];
#pragma unroll
                    for (int bj = 0; bj < 2; ++bj) {
                        float f[8], pa[8]; unpack8u(bj ? (u32x2){g[mm].z, g[mm].w} : (u32x2){g[mm].x, g[mm].y}, f); unpack8(a[mm][bj], pa);
                        f32x4 o0, o1;
#pragma unroll
                        for (int j = 0; j < 4; ++j) { o0[j] = (pa[j] + f[j] * acc[ai][bj][m][0][j] * (1.0f / (255.0f * 64.0f * OSCALE))) * MSCALE; o1[j] = (pa[4 + j] + f[4 + j] * acc[ai][bj][m][1][j] * (1.0f / (255.0f * 64.0f * OSCALE))) * MSCALE; }
                        w8[bj] = pk8_fp8(o0, o1);
                    }
                    *(u32x4*)(mix + (size_t)(row0 + ai * 128 + m * 16) * 2048 + pos) = (u32x4){w8[0].x, w8[0].y, w8[1].x, w8[1].y};
                }
            }
    }
};
struct EpiWo {
    static constexpr bool PERM = true; static constexpr int MID_T = -1; static constexpr bool FP8 = true;
    const float* x; const float* mod; bf16_t* r;
    __device__ __forceinline__ void operator()(const f32x4 (&acc)[2][2][4][2], const Unit& u, int wr, int wc, int fr, int fq) const {
        const int row0 = u.pm * 256 + wr * 64 + fr; const int b = (u.pm * 256) >> 13;
        const float* __restrict__ xx = x;
#pragma unroll
        for (int bj = 0; bj < 2; ++bj) {
            const int col = u.pn * 256 + bj * 128 + wc * 32 + 8 * fq;
            const f32x4 g0 = *(const f32x4*)(mod + b * 12288 + 2 * 2048 + col), g1 = *(const f32x4*)(mod + b * 12288 + 2 * 2048 + col + 4);
#pragma unroll
            for (int ai = 0; ai < 2; ++ai) {
                f32x4 x0[4], x1[4];
#pragma unroll
                for (int m = 0; m < 4; ++m) { const float* xr = xx + (size_t)(row0 + ai * 128 + m * 16) * 2048 + col; x0[m] = *(const f32x4*)xr; x1[m] = *(const f32x4*)(xr + 4); }
#pragma unroll
                for (int m = 0; m < 4; ++m) st8_bf16(r + (size_t)(row0 + ai * 128 + m * 16) * 2048 + col, x0[m] * DN_ALPHA + g0 * (acc[ai][bj][m][0] * (1.0f / (64.0f * MSCALE))), x1[m] * DN_ALPHA + g1 * (acc[ai][bj][m][1] * (1.0f / (64.0f * MSCALE))));
            }
        }
    }
};
struct EpiRouter {
    static constexpr bool PERM = false; static constexpr int MID_T = -1; static constexpr bool FP8 = false;
    float* logit;
    __device__ __forceinline__ void operator()(const f32x4 (&acc)[2][2][4][2], const Unit& u, int wr, int wc, int fr, int fq) const {
        const int row0 = u.pm * 256 + wr * 64 + fr;
        if (wc < 2) {
#pragma unroll
            for (int n = 0; n < 2; ++n)
#pragma unroll
                for (int ai = 0; ai < 2; ++ai)
#pragma unroll
                    for (int m = 0; m < 4; ++m) {
                        const int row = row0 + ai * 128 + m * 16, col = wc * 32 + n * 16 + 4 * fq;
                        *(f32x4*)(logit + (size_t)row * 64 + col) = acc[ai][0][m][n];
                    }
        }
    }
};
constexpr float WSCALE = 64.0f, HSCALE = 4.0f;
struct EpiExp1 {
    static constexpr bool PERM = true; static constexpr int MID_T = -1; static constexpr bool FP8 = true;
    unsigned char* hh;
    __device__ __forceinline__ void operator()(const f32x4 (&acc)[2][2][4][2], const Unit& u, int wr, int wc, int fr, int fq) const {
        const int row0 = u.pm * 256 + wr * 64 + fr;
#pragma unroll
        for (int ai = 0; ai < 2; ++ai)
#pragma unroll
            for (int m = 0; m < 4; ++m) {
                const int row = row0 + ai * 128 + m * 16, col = u.pn * 128 + wc * 32 + 8 * fq;
                f32x4 o0, o1;
#pragma unroll
                for (int j = 0; j < 4; ++j) { o0[j] = siluf_(acc[ai][0][m][0][j] * (1.0f / WSCALE)) * acc[ai][1][m][0][j] * (HSCALE / WSCALE);
                                              o1[j] = siluf_(acc[ai][0][m][1][j] * (1.0f / WSCALE)) * acc[ai][1][m][1][j] * (HSCALE / WSCALE); }
                *(u32x2*)(hh + (size_t)row * 512 + col) = pk8_fp8(o0, o1);
            }
    }
};
struct EpiExp2 {
    static constexpr bool PERM = true; static constexpr int MID_T = -1; static constexpr bool FP8 = true;
    unsigned char* y; const u32x2* wd; const bf16_t* t16; bf16_t* t16o; const float* mod;
    __device__ __forceinline__ void operator()(const f32x4 (&acc)[2][2][4][2], const Unit& u, int wr, int wc, int fr, int fq) const {
        const int row0 = u.pm * 256 + wr * 64 + fr;
        int dsts[2][4]; float wts[2][4];
#pragma unroll
        for (int ai = 0; ai < 2; ++ai)
#pragma unroll
            for (int m = 0; m < 4; ++m) { const u32x2 q = wd[row0 + ai * 128 + m * 16]; dsts[ai][m] = (int)q.y; wts[ai][m] = __uint_as_float(q.x) * (YSCALE / (WSCALE * HSCALE)); }
        if (u.e < 64) {
#pragma unroll
            for (int ai = 0; ai < 2; ++ai)
#pragma unroll
                for (int m = 0; m < 4; ++m) {
                    const int dst = dsts[ai][m]; const float w = wts[ai][m];
                    if (dst >= 0) {
                        const u32x2 lo = pk8_fp8(acc[ai][0][m][0] * w, acc[ai][0][m][1] * w), hi = pk8_fp8(acc[ai][1][m][0] * w, acc[ai][1][m][1] * w);
                        *(u32x4*)(y + (size_t)dst * 2048 + u.pn * 256 + wc * 64 + fq * 16) = (u32x4){lo.x, lo.y, hi.x, hi.y};
                    }
                }
        } else {
#pragma unroll
            for (int ai = 0; ai < 2; ++ai)
#pragma unroll
                for (int bj = 0; bj < 2; ++bj) {
                    const int col = u.pn * 256 + bj * 128 + wc * 32 + 8 * fq;
                    const float* gr = mod + (dsts[0][0] >> 13) * 12288 + 5 * 2048 + col;
                    const f32x4 g0 = *(const f32x4*)gr, g1 = *(const f32x4*)(gr + 4);
                    u32x4 xx[4];
#pragma unroll
                    for (int m = 0; m < 4; ++m) xx[m] = *(const u32x4*)(t16 + (size_t)dsts[ai][m] * 2048 + col);
#pragma unroll
                    for (int m = 0; m < 4; ++m) { float f[8]; unpack8(xx[m], f);
                        f32x4 o0, o1;
#pragma unroll
                        for (int j = 0; j < 4; ++j) { o0[j] = f[j] * DN_ALPHA + g0[j] * (acc[ai][bj][m][0][j] * (1.0f / (WSCALE * HSCALE))); o1[j] = f[4 + j] * DN_ALPHA + g1[j] * (acc[ai][bj][m][1][j] * (1.0f / (WSCALE * HSCALE))); }
                        st8_bf16(t16o + (size_t)dsts[ai][m] * 2048 + col, o0, o1); }
                }
        }
    }
};
struct Exp1Sched {
    static constexpr bool GATHER = true;
    const char* h2; const char* btgu; const int* tokof; const int* tilee; int ntiles, G, c; int lda, ldb;
    __device__ __forceinline__ bool next(int i, Unit& u) const {
        if (G == 256) { const int v = c & 7, r = c >> 3, grp = i * 8 + v, tile = grp * 8 + (r & 7); if (tile >= ntiles) return false; u.pm = tile; u.pn = r >> 3; }
        else { const int L = i * G + c; if (L >= ntiles * 4) return false; u.pm = L >> 2; u.pn = L & 3; }
        u.e = __builtin_amdgcn_readfirstlane(tilee[u.pm]); return true; }
    __device__ __forceinline__ const char* a_base(const Unit&) const { return h2; }
    __device__ __forceinline__ unsigned a_row_off(const Unit& u, int r) const { return (unsigned)tokof[u.pm * 256 + r] * 2048u; }
    __device__ __forceinline__ const char* b_base(const Unit& u) const { return btgu + ((size_t)u.e * 1024 + u.pn * 256) * 2048; }
};
struct Exp2Sched {
    static constexpr bool GATHER = false;
    const char* hh; const char* btd; const int* tilee; int ntiles, G, c; int lda, ldb;
    __device__ __forceinline__ bool next(int i, Unit& u) const {
        if (G == 256) { const int v = c & 7, r = c >> 3, grp = i * 8 + v, tile = grp * 4 + (r & 3); if (tile >= ntiles) return false; u.pm = tile; u.pn = r >> 2; }
        else { const int L = i * G + c; if (L >= ntiles * 8) return false; u.pm = L >> 3; u.pn = L & 7; }
        u.e = __builtin_amdgcn_readfirstlane(tilee[u.pm]); return true; }
    __device__ __forceinline__ const char* a_base(const Unit& u) const { return hh + (size_t)u.pm * 256 * 512; }
    __device__ __forceinline__ unsigned a_row_off(const Unit&, int) const { return 0u; }
    __device__ __forceinline__ const char* b_base(const Unit& u) const { return btd + ((size_t)u.e * 2048 + u.pn * 256) * 512; }
};
template <int NN> __device__ __forceinline__ gm::DenseSchedT<NN> dense(const void* A, int lda, const void* Bt, int ldb) {
    gm::DenseSchedT<NN> s; s.A = (const char*)A; s.Bt = (const char*)Bt; s.lda = lda; s.ldb = ldb; s.G = gridDim.x; s.c = blockIdx.x; return s; }
__device__ __forceinline__ void ph_smallnorm(const Params& p) {
    const bf16_t* psm = (const bf16_t*)(p.ws + O_PSM);
    bf16_t* cqn = (bf16_t*)(p.ws + O_CQN); bf16_t* kv = (bf16_t*)(p.ws + O_KV); bf16_t* kidx = (bf16_t*)(p.ws + O_KIDX); float* widx = (float*)(p.ws + O_WIDX);
    const int tid_ = opaque_tid(); const int lane = tid_ & 63, wv = tid_ >> 6;
    const f32x4 qg0 = *(const f32x4*)(p.qng + lane * 8), qg1 = *(const f32x4*)(p.qng + lane * 8 + 4);
    const int pc_ = lane < 16 ? lane * 8 : (lane < 24 ? (lane - 16) * 8 : 0);
    const float* gsrc = lane < 16 ? p.kvng : p.ikg;
    const f32x4 sg0 = *(const f32x4*)(gsrc + pc_), sg1 = *(const f32x4*)(gsrc + pc_ + 4), sb0 = *(const f32x4*)(p.ikb + (lane < 16 ? 0 : pc_)), sb1 = *(const f32x4*)(p.ikb + (lane < 16 ? 0 : pc_) + 4);
    const int srow0 = blockIdx.x * 8 + wv, sstride = gridDim.x * 8;
    u32x4 an = (u32x4){0u, 0u, 0u, 0u}, bn = an;
    if (srow0 < NT) { an = *(const u32x4*)(psm + (size_t)srow0 * 768 + lane * 8); if (lane < 26) bn = *(const u32x4*)(psm + (size_t)srow0 * 768 + 512 + lane * 8); }
#pragma unroll 1
    for (int row = srow0; row < NT; row += sstride) {
        const u32x4 a = an, bcur = bn;
        { const int rn = (row + sstride < NT) ? row + sstride : row; an = *(const u32x4*)(psm + (size_t)rn * 768 + lane * 8); if (lane < 26) bn = *(const u32x4*)(psm + (size_t)rn * 768 + 512 + lane * 8); }
        float f[8];
        f[0] = __uint_as_float(a.x << 16); f[1] = __uint_as_float(a.x & 0xffff0000u); f[2] = __uint_as_float(a.y << 16); f[3] = __uint_as_float(a.y & 0xffff0000u);
        f[4] = __uint_as_float(a.z << 16); f[5] = __uint_as_float(a.z & 0xffff0000u); f[6] = __uint_as_float(a.w << 16); f[7] = __uint_as_float(a.w & 0xffff0000u);
        float ss = 0.f;
#pragma unroll
        for (int j = 0; j < 8; ++j) ss += f[j] * f[j];
        const float r1 = rsqrtf(wave_sum(ss) * (1.0f / 512.0f) + LN_EPS);
        {
            const f32x4 g0 = qg0, g1 = qg1;
            u32x4 w; w.x = pk_bf16(f[0] * r1 * g0[0], f[1] * r1 * g0[1]); w.y = pk_bf16(f[2] * r1 * g0[2], f[3] * r1 * g0[3]);
            w.z = pk_bf16(f[4] * r1 * g1[0], f[5] * r1 * g1[1]); w.w = pk_bf16(f[6] * r1 * g1[2], f[7] * r1 * g1[3]);
            *(u32x4*)(cqn + (size_t)row * 512 + lane * 8) = w;
        }
        float g[8];
        {
            const u32x4 b = (lane < 26) ? bcur : (u32x4){0u, 0u, 0u, 0u};
            g[0] = __uint_as_float(b.x << 16); g[1] = __uint_as_float(b.x & 0xffff0000u); g[2] = __uint_as_float(b.y << 16); g[3] = __uint_as_float(b.y & 0xffff0000u);
            g[4] = __uint_as_float(b.z << 16); g[5] = __uint_as_float(b.z & 0xffff0000u); g[6] = __uint_as_float(b.w << 16); g[7] = __uint_as_float(b.w & 0xffff0000u);
        }
        float s1 = 0.f, s2 = 0.f;
#pragma unroll
        for (int j = 0; j < 8; ++j) { s1 += g[j]; s2 += g[j] * g[j]; }
        const float kvss = wave_sum(lane < 16 ? s2 : 0.f);
        const float kis = wave_sum((lane >= 16 && lane < 24) ? s1 : 0.f);
        const float mu = kis * (1.0f / 64.0f);
        float dq = 0.f;
#pragma unroll
        for (int j = 0; j < 8; ++j) dq += (g[j] - mu) * (g[j] - mu);
        const float kiv = wave_sum((lane >= 16 && lane < 24) ? dq : 0.f) * (1.0f / 64.0f);
        if (lane < 16) {
            const float r2 = rsqrtf(kvss * (1.0f / 128.0f) + LN_EPS);
            const f32x4 g0 = sg0, g1 = sg1;
            u32x4 w; w.x = pk_bf16(g[0] * r2 * g0[0], g[1] * r2 * g0[1]); w.y = pk_bf16(g[2] * r2 * g0[2], g[3] * r2 * g0[3]);
            w.z = pk_bf16(g[4] * r2 * g1[0], g[5] * r2 * g1[1]); w.w = pk_bf16(g[6] * r2 * g1[2], g[7] * r2 * g1[3]);
            *(u32x4*)(kv + (size_t)row * 128 + lane * 8) = w;
        } else if (lane < 24) {
            const int c = (lane - 16) * 8; const float r3 = rsqrtf(kiv + LN_EPS);
            const f32x4 g0 = sg0, g1 = sg1, b0 = sb0, b1 = sb1;
            u32x4 w; w.x = pk_bf16((g[0] - mu) * r3 * g0[0] + b0[0], (g[1] - mu) * r3 * g0[1] + b0[1]); w.y = pk_bf16((g[2] - mu) * r3 * g0[2] + b0[2], (g[3] - mu) * r3 * g0[3] + b0[3]);
            w.z = pk_bf16((g[4] - mu) * r3 * g1[0] + b1[0], (g[5] - mu) * r3 * g1[1] + b1[1]); w.w = pk_bf16((g[6] - mu) * r3 * g1[2] + b1[2], (g[7] - mu) * r3 * g1[3] + b1[3]);
            *(u32x4*)(kidx + (size_t)row * 64 + c) = w;
        } else if (lane < 26) {
            const int c = (lane - 24) * 8;
            *(f32x4*)(widx + (size_t)row * 16 + c) = (f32x4){g[0], g[1], g[2], g[3]} * 0.03125f;
            *(f32x4*)(widx + (size_t)row * 16 + c + 4) = (f32x4){g[4], g[5], g[6], g[7]} * 0.03125f;
        }
    }
}

__device__ __forceinline__ unsigned short score_key(float s) {
    const unsigned short h = __builtin_bit_cast(unsigned short, (_Float16)s);
    const unsigned short m = (unsigned short)((short)h >> 15);
    return (unsigned short)(h ^ (m | 0x8000u));
}
__device__ __forceinline__ int wave_sum_fast(int v) {
    v += __builtin_amdgcn_update_dpp(0, v, 0xB1, 0xf, 0xf, false);
    v += __builtin_amdgcn_update_dpp(0, v, 0x4E, 0xf, 0xf, false);
    v += __builtin_amdgcn_update_dpp(0, v, 0x141, 0xf, 0xf, false);
    v += __builtin_amdgcn_update_dpp(0, v, 0x140, 0xf, 0xf, false);
    u32x2 r = __builtin_amdgcn_permlane16_swap(v, v, false, false); v = r[0] + r[1];
    r = __builtin_amdgcn_permlane32_swap(v, v, false, false); v = r[0] + r[1];
    return v;
}
__device__ __forceinline__ unsigned cnt_ge4(unsigned cnt, const u32x4& v, unsigned tm1pk) {
    unsigned t0, t1, t2, t3;
    asm("v_pk_sub_u16 %0, %1, %2 clamp" : "=v"(t0) : "v"(v.x), "v"(tm1pk));
    asm("v_pk_sub_u16 %0, %1, %2 clamp" : "=v"(t1) : "v"(v.y), "v"(tm1pk));
    asm("v_pk_sub_u16 %0, %1, %2 clamp" : "=v"(t2) : "v"(v.z), "v"(tm1pk));
    asm("v_pk_sub_u16 %0, %1, %2 clamp" : "=v"(t3) : "v"(v.w), "v"(tm1pk));
    const unsigned one = 0x00010001u;
    asm("v_pk_min_u16 %0, %1, %2" : "=v"(t0) : "v"(t0), "v"(one));
    asm("v_pk_min_u16 %0, %1, %2" : "=v"(t1) : "v"(t1), "v"(one));
    asm("v_pk_min_u16 %0, %1, %2" : "=v"(t2) : "v"(t2), "v"(one));
    asm("v_pk_min_u16 %0, %1, %2" : "=v"(t3) : "v"(t3), "v"(one));
    asm("v_pk_add_u16 %0, %1, %2" : "=v"(t0) : "v"(t0), "v"(t1));
    asm("v_pk_add_u16 %0, %1, %2" : "=v"(t2) : "v"(t2), "v"(t3));
    asm("v_pk_add_u16 %0, %1, %2" : "=v"(t0) : "v"(t0), "v"(t2));
    asm("v_pk_add_u16 %0, %1, %2" : "=v"(cnt) : "v"(cnt), "v"(t0));
    return cnt;
}
typedef _Float16 h2_t __attribute__((ext_vector_type(2)));
typedef short s2_t __attribute__((ext_vector_type(2)));
__device__ __forceinline__ float relu_(float x) { return __builtin_amdgcn_fmed3f(x, 0.0f, __builtin_inff()); }
__device__ __forceinline__ void ph_indexer(const Params& p, ldsp_t lds, const int nsel_rep) {
    const bf16_t* qidx = (const bf16_t*)(p.ws + O_QIDX); const bf16_t* kidx = (const bf16_t*)(p.ws + O_KIDX); const float* widx = (const float*)(p.ws + O_WIDX);
    u16* sel = (u16*)(p.ws + O_SEL);
    LAS u16* sc = (LAS u16*)lds;
    ldsp_t kt = lds + 32768;
    unsigned bwo = LDS_BYTES - 16; asm volatile("" : "+v"(bwo));
    const LAS unsigned* bwp = (const LAS unsigned*)(lds + bwo);
    const unsigned bw0 = __builtin_amdgcn_readfirstlane(bwp[0]), bw1 = __builtin_amdgcn_readfirstlane(bwp[1]), bw2 = __builtin_amdgcn_readfirstlane(bwp[2]), bw3 = __builtin_amdgcn_readfirstlane(bwp[3]);
    __syncthreads();
    const int tid = opaque_tid(), lane = tid & 63, wv = __builtin_amdgcn_readfirstlane(tid >> 6), rb = wv & 3, kb = wv >> 2;
    const int l31 = lane & 31, hh = lane >> 5;
    const int drow = 8 * wv + (lane >> 3), dchunk = (lane & 7) ^ ((drow >> 1) & 7);
    const int krow = kb * 32 + l31;
    unsigned boff[4];
#pragma unroll
    for (int kk = 0; kk < 4; ++kk) boff[kk] = (unsigned)(krow * 128 + (((2 * kk + hh) ^ ((krow >> 1) & 7)) * 16));
    typedef float f32x16 __attribute__((ext_vector_type(16)));
    const bool xmap = gridDim.x == 256;
    const int xwi = ((blockIdx.x & 1) * 32) + (blockIdx.x >> 3);
    for (int ui = 0;; ++ui) {
        int b, qt;
        if (xmap) { if (ui >= 16) break; b = (blockIdx.x & 7) >> 1; qt = 1023 - (((ui & 1) ? 63 - xwi : xwi) + 64 * ui); }
        else { const int unit = blockIdx.x + ui * gridDim.x; if (unit >= NT / 8) break; b = unit & 3; qt = 1023 - (unit >> 2); }
        const int t0 = qt * 8, g0 = b * SEQ + t0;
        const int nkeys = ((t0 + 8 + 511) >> 9) << 9;
        const int nst = nkeys >> 8;
        bf16x8 af[4];
        {
            const int row = l31, q = 2 * rb + (row >> 4), h = row & 15;
            const bf16_t* src = qidx + (size_t)(g0 + q) * 1024 + h * 64 + 8 * hh;
#pragma unroll
            for (int kk = 0; kk < 4; ++kk) af[kk] = *(const bf16x8*)(src + 16 * kk);
        }
        h2_t wq0[4], wq1[4];
#pragma unroll
        for (int i = 0; i < 4; ++i) { const int h = ((2 * i) & 3) + 8 * ((2 * i) >> 2) + 4 * hh;
            wq0[i] = (h2_t){(_Float16)widx[(size_t)(g0 + 2 * rb) * 16 + h], (_Float16)widx[(size_t)(g0 + 2 * rb) * 16 + h + 1]};
            wq1[i] = (h2_t){(_Float16)widx[(size_t)(g0 + 2 * rb + 1) * 16 + h], (_Float16)widx[(size_t)(g0 + 2 * rb + 1) * 16 + h + 1]}; }
        const int myq = t0 + 2 * rb + hh;
        const bf16_t* ksrc = kidx + ((size_t)b * SEQ + drow) * 64 + dchunk * 8;
        LAS u16* scw = sc + (2 * rb + hh) * 2048 + kb * 32 + l31;
        const int t = t0 + wv, n = t + 1;
        const int nch = (n + 511) >> 9;
        const LAS u16* srow = sc + wv * 2048;
        u32x4 kr[16];
#pragma unroll
        for (int ch = 0; ch < 16; ++ch) kr[ch] = (u32x4){0u, 0u, 0u, 0u};
        auto score_pass = [&](const int s0, const int s1) {
            asm volatile("s_waitcnt lgkmcnt(0)" ::: "memory");
            __builtin_amdgcn_s_barrier(); asm volatile("" ::: "memory");
            if (s0 == 0) {
#pragma unroll
                for (int j = 0; j < 4; ++j) __builtin_amdgcn_global_load_lds((const unsigned*)(ksrc + (size_t)(j) * 4096), (LAS unsigned*)(kt + j * 8192 + wv * 1024), 16, 0, 0);
#pragma unroll
                for (int j = 0; j < 4; ++j) __builtin_amdgcn_global_load_lds((const unsigned*)(ksrc + (size_t)(4 + j) * 4096), (LAS unsigned*)(kt + 32768 + j * 8192 + wv * 1024), 16, 0, 0);
                if (2 < nst) {
#pragma unroll
                    for (int j = 0; j < 4; ++j) __builtin_amdgcn_global_load_lds((const unsigned*)(ksrc + (size_t)(8 + j) * 4096), (LAS unsigned*)(kt + 65536 + j * 8192 + wv * 1024), 16, 0, 0);
                    asm volatile("s_waitcnt vmcnt(8)" ::: "memory");
                } else asm volatile("s_waitcnt vmcnt(4)" ::: "memory");
            }
            asm volatile("" : "+v"(af[0]), "+v"(af[1]), "+v"(af[2]), "+v"(af[3]));
            asm volatile("" : "+v"(wq0[0]), "+v"(wq0[1]), "+v"(wq0[2]), "+v"(wq0[3]), "+v"(wq1[0]), "+v"(wq1[1]), "+v"(wq1[2]), "+v"(wq1[3]));
            __builtin_amdgcn_s_barrier(); asm volatile("" ::: "memory");
            int slot = 0;
#pragma unroll 1
            for (int st = s0; st < s1; ++st) {
                const int ahead = nst - 1 - st;
                if (ahead >= 3) { const int ns = (slot + 98304) & 131071;
#pragma unroll
                    for (int j = 0; j < 4; ++j) __builtin_amdgcn_global_load_lds((const unsigned*)(ksrc + (size_t)((st + 3) * 4 + j) * 4096), (LAS unsigned*)(kt + ns + j * 8192 + wv * 1024), 16, 0, 0);
                }
                ldsp_t kb_ = kt + slot;
                const f32x16 zero16 = {0.f, 0.f, 0.f, 0.f, 0.f, 0.f, 0.f, 0.f, 0.f, 0.f, 0.f, 0.f, 0.f, 0.f, 0.f, 0.f};
#define SC_MMA(ACC, j_) do { bf16x8 bq_[4]; _Pragma("unroll") for (int kk = 0; kk < 4; ++kk) bq_[kk] = *(const LAS bf16x8*)(kb_ + (j_) * 8192 + boff[kk]); \
                    asm volatile("" : "+v"(bq_[0]), "+v"(bq_[1]), "+v"(bq_[2]), "+v"(bq_[3]));     \
                    ACC = zero16; _Pragma("unroll") for (int kk = 0; kk < 4; ++kk) ACC = __builtin_amdgcn_mfma_f32_32x32x16_bf16(af[kk], bq_[kk], ACC, 0, 0, 0); } while (0)
#define SC_TILE(ACC, j_) do { float sa = 0.f, sb = 0.f; \
                    _Pragma("unroll") for (int i = 0; i < 4; ++i) { \
                        const s2_t ra = __builtin_elementwise_max(__builtin_bit_cast(s2_t, __builtin_amdgcn_cvt_pkrtz(ACC[2 * i], ACC[2 * i + 1])), (s2_t){0, 0}); \
                        const s2_t rb_ = __builtin_elementwise_max(__builtin_bit_cast(s2_t, __builtin_amdgcn_cvt_pkrtz(ACC[8 + 2 * i], ACC[9 + 2 * i])), (s2_t){0, 0}); \
                        sa = __builtin_amdgcn_fdot2(__builtin_bit_cast(h2_t, ra), wq0[i], sa, false); \
                        sb = __builtin_amdgcn_fdot2(__builtin_bit_cast(h2_t, rb_), wq1[i], sb, false); } \
                    const u32x2 sw = __builtin_amdgcn_permlane32_swap(__float_as_uint(sa), __float_as_uint(sb), false, false); \
                    const float s = __uint_as_float(sw[0]) + __uint_as_float(sw[1]); \
                    const int kidx_ = st * 256 + (j_) * 64 + kb * 32 + l31; \
                    scw[(st - s0) * 256 + (j_) * 64] = (kidx_ <= myq) ? score_key(s) : (unsigned short)0; } while (0)
                f32x16 accA, accB;
                SC_MMA(accA, 0);
                SC_MMA(accB, 1); SC_TILE(accA, 0);
                SC_MMA(accA, 2); SC_TILE(accB, 1);
                SC_MMA(accB, 3); SC_TILE(accA, 2);
                SC_TILE(accB, 3);
#undef SC_MMA
#undef SC_TILE
                slot = (slot + 32768) & 131071;
                if (ahead >= 3) asm volatile("s_waitcnt vmcnt(8) lgkmcnt(0)" ::: "memory");
                else if (ahead == 2) asm volatile("s_waitcnt vmcnt(4) lgkmcnt(0)" ::: "memory");
                else asm volatile("s_waitcnt vmcnt(0) lgkmcnt(0)" ::: "memory");
                __builtin_amdgcn_s_barrier(); asm volatile("" ::: "memory");
            }
        };
#define IDX_PASS(P) if (nst > 8 * (P)) { score_pass(8 * (P), nst < 8 * (P) + 8 ? nst : 8 * (P) + 8); \
            _Pragma("unroll") for (int ch = 4 * (P); ch < 4 * (P) + 4; ++ch) if (ch < nch) kr[ch] = *(const LAS u32x4*)(srow + (ch - 4 * (P)) * 512 + lane * 8); }
        IDX_PASS(0) IDX_PASS(1) IDX_PASS(2) IDX_PASS(3)
#undef IDX_PASS
        if (nsel_rep) {
            u16* sog = sel + (size_t)(g0 + wv) * 256;
            LAS u16* so = (LAS u16*)(kt + wv * 512);
            if (n <= 256) {
#pragma unroll
                for (int i = 0; i < 4; ++i) { const int j = i * 64 + lane; so[j] = (u16)(j < n ? j : 0); }
            } else {
                unsigned T = 0;
#pragma unroll 1
                for (int bit = 15; bit >= 0; --bit) {
                    const unsigned Tc = T | (1u << bit), tm1 = Tc - 1u, tpk = tm1 | (tm1 << 16);
                    unsigned c2 = 0;
#pragma unroll
                    for (int ch = 0; ch < 4; ++ch) c2 = cnt_ge4(c2, kr[ch], tpk);
                    if (nch > 4) {
#pragma unroll
                        for (int ch = 4; ch < 8; ++ch) c2 = cnt_ge4(c2, kr[ch], tpk);
                        if (nch > 8) {
#pragma unroll
                            for (int ch = 8; ch < 12; ++ch) c2 = cnt_ge4(c2, kr[ch], tpk);
                            if (nch > 12) {
#pragma unroll
                                for (int ch = 12; ch < 16; ++ch) c2 = cnt_ge4(c2, kr[ch], tpk);
                            }
                        }
                    }
                    const int cnt = __builtin_amdgcn_readfirstlane(wave_sum_fast((int)(c2 & 0xffffu) + (int)(c2 >> 16)));
                    if (cnt >= TOPK) T = Tc;
                    if (cnt == TOPK) break;
                }
                int base = 0;
                const unsigned long long lt = (1ull << lane) - 1ull;
#pragma unroll
                for (int ch = 0; ch < 16; ++ch) {
                    if (ch < nch) {
#pragma unroll
                        for (int j = 0; j < 8; ++j) {
                            const unsigned d = kr[ch][j >> 1]; const unsigned key = (j & 1) ? (d >> 16) : (d & 0xffffu);
                            const bool gt = key > T;
                            const unsigned long long m = __ballot(gt);
                            if (gt) so[base + __popcll(m & lt)] = (u16)(ch * 512 + lane * 8 + j);
                            base += __popcll(m);
                        }
                    }
                }
                int need = TOPK - base;
#pragma unroll
                for (int ch = 0; ch < 16; ++ch) {
                    if (ch < nch && need > 0) {
                        const unsigned tpk2 = T | (T << 16);
                        bool anyeq = false;
#pragma unroll
                        for (int dq = 0; dq < 4; ++dq) { const unsigned x = kr[ch][dq] ^ tpk2; anyeq |= ((x & 0xffffu) == 0u) | ((x >> 16) == 0u); }
                        if (__ballot(anyeq) == 0ull) continue;
#pragma unroll
                        for (int j = 0; j < 8; ++j) {
                            const unsigned d = kr[ch][j >> 1]; const unsigned key = (j & 1) ? (d >> 16) : (d & 0xffffu);
                            const bool eq = key == T;
                            const unsigned long long m = __ballot(eq);
                            const int rk = __popcll(m & lt);
                            if (eq && rk < need) so[base + rk] = (u16)(ch * 512 + lane * 8 + j);
                            const int tk = __popcll(m); const int took = tk < need ? tk : need;
                            base += took; need -= took;
                        }
                    }
                }
            }
            *(u32x2*)(sog + lane * 4) = *(const LAS u32x2*)(so + lane * 4);
        }
    }
    asm volatile("s_waitcnt vmcnt(0) lgkmcnt(0)" ::: "memory");
    __syncthreads();
    if (opaque_tid() == 0) *(LAS u32x4*)(lds + LDS_BYTES - 16) = (u32x4){bw0, bw1, bw2, bw3};
    __syncthreads();
}

__device__ __forceinline__ unsigned kv_off(unsigned row, unsigned ch) { return 256u * row + 16u * (ch ^ (((row & 3) << 2) | ((row >> 2) & 3))); }
__device__ __forceinline__ void ph_attn(const Params& p, ldsp_t lds) {
    const bf16_t* qlat = (const bf16_t*)(p.ws + O_QLAT); const bf16_t* kv = (const bf16_t*)(p.ws + O_KV); const u16* sel = (const u16*)(p.ws + O_SEL);
    bf16_t* olat = (bf16_t*)(p.ws + O_OLAT);
    const int tid = opaque_tid(), lane = tid & 63, wv = __builtin_amdgcn_readfirstlane(tid >> 6);
    ldsp_t img = lds + wv * 8192;
    LAS u16* selB = (LAS u16*)(lds + 65536 + wv * 1024);
    LAS float* tab = (LAS float*)(lds + 65536 + 8192);
    for (int i = tid; i < 2048; i += NTHREADS) { const int d = i >> 4; int bk; if (d < 16) bk = d; else { bk = 16 + (int)(__log2f((float)d * 0.0625f) * (16.0f / 3.0f)); if (bk > 31) bk = 31; }
        tab[i] = p.rpb[bk * 16 + (i & 15)]; }
    __syncthreads();
    const int hd = lane & 15, g = lane >> 4;
    const bool xmap = gridDim.x == 256;
    const int qstride = xmap ? 512 : (int)gridDim.x * 8;
    const int tok0 = xmap ? (((blockIdx.x & 7) >> 1) * SEQ + (((blockIdx.x & 1) * 32 + (blockIdx.x >> 3)) * 8) + wv) : (int)(blockIdx.x * 8 + wv);
    const int tok_end = xmap ? (((blockIdx.x & 7) >> 1) + 1) * SEQ : NT;
    const int nq = tok0 < tok_end ? (tok_end - tok0 + qstride - 1) / qstride : 0;
    const int nchunks = nq * 8;
    u32x4 stA[8], stB[8];
#define ATT_GATHER(ST, n_) do { const int qi_ = (n_) >> 3, ch_ = (n_) & 7; const int tk_ = tok0 + qi_ * qstride; const bf16_t* kvb_ = kv + (size_t)(tk_ >> 13) * SEQ * 128; \
        _Pragma("unroll") for (int it = 0; it < 8; ++it) { const int pc = it * 64 + lane, r = pc >> 4, c16 = pc & 15; const int ki = selB[(qi_ & 1) * 256 + ch_ * 32 + r]; \
            ST[it] = *(const u32x4*)(kvb_ + (size_t)ki * 128 + c16 * 8); } } while (0)
#define ATT_STAGE(ST) do { _Pragma("unroll") for (int it = 0; it < 8; ++it) { const int pc = it * 64 + lane, r = pc >> 4, c16 = pc & 15; *(LAS u32x4*)(img + kv_off(r, c16)) = ST[it]; } } while (0)
    bf16x8 qf[4];
    if (nq > 0) {
        const u32x2 s4 = *(const u32x2*)(sel + (size_t)tok0 * 256 + lane * 4); *(LAS u32x2*)(selB + lane * 4) = s4;
#pragma unroll
        for (int kk = 0; kk < 4; ++kk) qf[kk] = *(const bf16x8*)(qlat + (size_t)tok0 * 2048 + hd * 128 + 32 * kk + 8 * g);
        ATT_GATHER(stA, 0); ATT_GATHER(stB, 1);
    }
#pragma unroll 1
    for (int qi = 0; qi < nq; ++qi) {
        const int tok = tok0 + qi * qstride, t = tok & (SEQ - 1);
        const int nsel = (t + 1) < TOPK ? (t + 1) : TOPK;
        const int buf = qi & 1;
        const int tokn = (qi + 1 < nq) ? tok + qstride : tok;
        const u32x2 sn = *(const u32x2*)(sel + (size_t)tokn * 256 + lane * 4);
        bf16x8 qn[4];
#pragma unroll
        for (int kk = 0; kk < 4; ++kk) qn[kk] = *(const bf16x8*)(qlat + (size_t)tokn * 2048 + hd * 128 + 32 * kk + 8 * g);
        f32x4 o[8];
#pragma unroll
        for (int mb = 0; mb < 8; ++mb) o[mb] = (f32x4){0.f, 0.f, 0.f, 0.f};
        float mrun = -1e30f, lrun = 0.f;
        auto compute = [&](const int ch) {
            float bias[2][4];
#pragma unroll
            for (int blk = 0; blk < 2; ++blk) {
                const u32x2 k4 = *(const LAS u32x2*)(selB + buf * 256 + ch * 32 + 16 * blk + 4 * g);
#pragma unroll
                for (int r = 0; r < 4; ++r) {
                    const int pos = ch * 32 + 16 * blk + 4 * g + r;
                    const int ki = (int)(((r & 2) ? k4.y : k4.x) >> ((r & 1) * 16)) & 0xffff;
                    int dist = t - ki; dist = dist < 0 ? 0 : (dist > 127 ? 127 : dist);
                    float tv = tab[dist * 16 + hd]; asm volatile("" : "+v"(tv));
                    bias[blk][r] = (pos < nsel) ? tv : -1e30f;
                }
            }
            f32x4 s[2];
#pragma unroll
            for (int blk = 0; blk < 2; ++blk) {
                s[blk] = (f32x4){0.f, 0.f, 0.f, 0.f};
#pragma unroll
                for (int kk = 0; kk < 4; ++kk) {
                    const bf16x8 a = *(const LAS bf16x8*)(img + kv_off(hd + 16 * blk, 4 * kk + g));
                    s[blk] = __builtin_amdgcn_mfma_f32_16x16x32_bf16(a, qf[kk], s[blk], 0, 0, 0);
                }
            }
            float mx = -1e30f;
#pragma unroll
            for (int blk = 0; blk < 2; ++blk)
#pragma unroll
                for (int r = 0; r < 4; ++r) { const float v = s[blk][r] + bias[blk][r]; s[blk][r] = v; mx = fmaxf(mx, v); }
            { u32x2 rr = __builtin_amdgcn_permlane16_swap(__float_as_uint(mx), __float_as_uint(mx), false, false); mx = fmaxf(__uint_as_float(rr[0]), __uint_as_float(rr[1]));
              rr = __builtin_amdgcn_permlane32_swap(__float_as_uint(mx), __float_as_uint(mx), false, false); mx = fmaxf(__uint_as_float(rr[0]), __uint_as_float(rr[1])); }
            const float mnew = fmaxf(mrun, mx), scl = __expf(mrun - mnew);
            float ps = 0.f;
#pragma unroll
            for (int blk = 0; blk < 2; ++blk)
#pragma unroll
                for (int r = 0; r < 4; ++r) { const float e = __expf(s[blk][r] - mnew); s[blk][r] = e; ps += e; }
            { u32x2 rr = __builtin_amdgcn_permlane16_swap(__float_as_uint(ps), __float_as_uint(ps), false, false); ps = __uint_as_float(rr[0]) + __uint_as_float(rr[1]);
              rr = __builtin_amdgcn_permlane32_swap(__float_as_uint(ps), __float_as_uint(ps), false, false); ps = __uint_as_float(rr[0]) + __uint_as_float(rr[1]); }
            lrun = lrun * scl + ps; mrun = mnew;
#pragma unroll
            for (int mb = 0; mb < 8; ++mb) o[mb] *= scl;
            bf16x8 pf;
            { const u32x4 w = (u32x4){pk_bf16(s[0][0], s[0][1]), pk_bf16(s[0][2], s[0][3]), pk_bf16(s[1][0], s[1][1]), pk_bf16(s[1][2], s[1][3])}; pf = __builtin_bit_cast(bf16x8, w); }
#pragma unroll
            for (int mb = 0; mb < 8; ++mb) {
                const unsigned qq = (lane & 15) >> 2, pp = lane & 3;
                const unsigned a0 = kv_off(4 * g + qq, 2 * mb + (pp >> 1)) + 8 * (pp & 1);
                const unsigned a1 = kv_off(16 + 4 * g + qq, 2 * mb + (pp >> 1)) + 8 * (pp & 1);
                const s16x4 t0_ = __builtin_amdgcn_ds_read_tr16_b64_v4i16((LAS s16x4*)(img + a0));
                const s16x4 t1_ = __builtin_amdgcn_ds_read_tr16_b64_v4i16((LAS s16x4*)(img + a1));
                const bf16x8 af = (bf16x8){t0_[0], t0_[1], t0_[2], t0_[3], t1_[0], t1_[1], t1_[2], t1_[3]};
                o[mb] = __builtin_amdgcn_mfma_f32_16x16x32_bf16(af, pf, o[mb], 0, 0, 0);
            }
        };
#pragma unroll
        for (int ch = 0; ch < 8; ch += 2) {
            const int n = qi * 8 + ch;
            if (ch == 4) *(LAS u32x2*)(selB + (buf ^ 1) * 256 + lane * 4) = sn;
            ATT_STAGE(stA);
            if (n + 2 < nchunks) ATT_GATHER(stA, n + 2);
            compute(ch);
            ATT_STAGE(stB);
            if (n + 3 < nchunks) ATT_GATHER(stB, n + 3);
            compute(ch + 1);
        }
        const float inv = OSCALE / lrun;
        unsigned w8[8];
#pragma unroll
        for (int mb = 0; mb < 8; ++mb) {
            int w = 0; w = __builtin_amdgcn_cvt_pk_fp8_f32(o[mb][0] * inv, o[mb][1] * inv, w, false); w = __builtin_amdgcn_cvt_pk_fp8_f32(o[mb][2] * inv, o[mb][3] * inv, w, true); w8[mb] = (unsigned)w; }
        *(u32x4*)((unsigned char*)olat + (size_t)tok * 3072 + hd * 128 + g * 32) = (u32x4){w8[0], w8[1], w8[2], w8[3]};
        *(u32x4*)((unsigned char*)olat + (size_t)tok * 3072 + hd * 128 + g * 32 + 16) = (u32x4){w8[4], w8[5], w8[6], w8[7]};
#pragma unroll
        for (int kk = 0; kk < 4; ++kk) qf[kk] = qn[kk];
    }
#undef ATT_GATHER
#undef ATT_STAGE
    __syncthreads();
}
namespace hg {
constexpr int L_QT = 0, L_KT = 4096, L_KHT = 8192, L_VT = 16384, L_DV = 24576, L_ATT = 25088, L_SSQ = 33280, L_RAW = 33792, L_END = L_RAW + 2 * 12288;
__device__ __forceinline__ unsigned off16(unsigned row, unsigned ch) { return 256u * row + 16u * (ch ^ (((row & 3) << 2) | ((row >> 2) & 3))); }
__device__ __forceinline__ unsigned offT(unsigned row, unsigned ch) { return 64u * row + 16u * (ch ^ ((row >> 2) & 3)); }

template <int PASS>
__device__ __forceinline__ void run(const Params& p, ldsp_t lds) {
    const _Float16* LF = (const _Float16*)(p.ws + O_LF); const bf16_t* QB = (const bf16_t*)(p.ws + O_QB); const bf16_t* VV = (const bf16_t*)(p.ws + O_V); const bf16_t* GG = (const bf16_t*)(p.ws + O_G);
    float* HST = (float*)(p.ws + O_HST); float* HDEC = (float*)(p.ws + O_HDEC); bf16_t* OB = (bf16_t*)(p.ws + O_OLAT);
    const int tid = opaque_tid(), lane = tid & 63, wv = __builtin_amdgcn_readfirstlane(tid >> 6);
    const int l15 = lane & 15, g = lane >> 4;
    const int k = tid & 127, ig = tid >> 7;
    for (int i = tid; i < (L_ATT + 8192 - L_KHT) / 16; i += NTHREADS) *(LAS u32x4*)(lds + L_KHT + i * 16) = (u32x4){0u, 0u, 0u, 0u};
    __syncthreads();
    for (int s = blockIdx.x; s < 256; s += gridDim.x) {
        const int seg = s & 7, h = (s >> 3) & 7, b = s >> 6;
        if (PASS == 1 && seg == 7) continue;
        const size_t tok0 = (size_t)b * SEQ + (size_t)seg * HSEGL;
        const size_t cbase = (size_t)h * 128;
        f32x4 S[8];
#pragma unroll
        for (int mb = 0; mb < 8; ++mb) S[mb] = (f32x4){0.f, 0.f, 0.f, 0.f};
        if (PASS == 3) {
#pragma unroll 2
            for (int gp = 0; gp < seg; ++gp) {
                const int sp = (s & ~7) + gp;
                const float* Lp = HST + ((size_t)sp * 512 + tid) * 32; const float* Dp = HDEC + (size_t)sp * 128 + 4 * g;
#pragma unroll
                for (int mb = 0; mb < 8; ++mb) S[mb] = S[mb] * *(const f32x4*)(Dp + 16 * mb) + *(const f32x4*)(Lp + 4 * mb);
            }
        }
        float lfsum = 0.f;
        const float gn = (PASS == 3) ? p.hong[16 * wv + l15] : 0.f;
        const int rrow = tid >> 5, rc4 = (tid & 31) * 4;
        const unsigned goff0 = (unsigned)(rrow * 1024 + rc4);
        const _Float16* lfb = LF + tok0 * 1024 + cbase; const bf16_t* vbp = VV + tok0 * 1024 + cbase; const bf16_t* qbp = QB + tok0 * 1024 + cbase;
        const unsigned rawo = (unsigned)(rrow * 256 + rc4 * 2);
        u32x2 rl, rv, rq = (u32x2){0u, 0u};
        rl = *(const u32x2*)(lfb + goff0); rv = *(const u32x2*)(vbp + goff0); if (PASS == 3) rq = *(const u32x2*)(qbp + goff0);
        __syncthreads();
        *(LAS u32x2*)(lds + L_RAW + rawo) = rl; *(LAS u32x2*)(lds + L_RAW + 4096 + rawo) = rv; if (PASS == 3) *(LAS u32x2*)(lds + L_RAW + 8192 + rawo) = rq;
        rl = *(const u32x2*)(lfb + goff0 + 16 * 1024); rv = *(const u32x2*)(vbp + goff0 + 16 * 1024); if (PASS == 3) rq = *(const u32x2*)(qbp + goff0 + 16 * 1024);
        __syncthreads();
#pragma unroll 1
        for (int mc = 0; mc < HSEGL / 16; ++mc) {
            const size_t tb = tok0 + (size_t)mc * 16;
            bf16_t gq[4] = {0, 0, 0, 0};
            if (PASS == 3) {
#pragma unroll
                for (int r = 0; r < 4; ++r) gq[r] = GG[(tb + 4 * g + r) * 1024 + cbase + 16 * wv + l15];
            }
            {
                ldsp_t raw = lds + L_RAW + (mc & 1) * 12288;
                float btot = 0.f, bpre = 0.f;
#pragma unroll
                for (int i = 0; i < 16; ++i) { const float x = (float)*(const LAS _Float16*)(raw + i * 256 + k * 2); btot += x; bpre += (i < 4 * ig) ? x : 0.f; }
                lfsum += btot;
                unsigned khp[2], vtp[2];
                float bi = bpre;
#pragma unroll
                for (int i = 0; i < 4; ++i) {
                    const int ti = 4 * ig + i;
                    const float lfi = (float)*(const LAS _Float16*)(raw + (4 * ig + i) * 256 + k * 2);
                    bi += lfi;
                    const float kk_ = 1.0f - __expf(lfi);
                    const float kh = kk_ * __expf(btot - bi);
                    if (PASS == 3) {
                        const float qt = bf2f(*(const LAS bf16_t*)(raw + 8192 + (4 * ig + i) * 256 + k * 2)) * __expf(bi);
                        const float kt = kk_ * __expf(fminf(-bi, 85.0f));
                        *(LAS bf16_t*)(lds + L_QT + off16(ti, k >> 3) + (k & 7) * 2) = f2bf(qt);
                        *(LAS bf16_t*)(lds + L_KT + off16(ti, k >> 3) + (k & 7) * 2) = f2bf(kt);
                    }
                    const unsigned khb = f2bf(kh), vb_ = *(const LAS bf16_t*)(raw + 4096 + (4 * ig + i) * 256 + k * 2);
                    if (i & 1) { khp[i >> 1] |= khb << 16; vtp[i >> 1] |= vb_ << 16; } else { khp[i >> 1] = khb; vtp[i >> 1] = vb_; }
                }
                *(LAS u32x2*)(lds + L_KHT + offT(k, ig >> 1) + 8 * (ig & 1)) = (u32x2){khp[0], khp[1]};
                *(LAS u32x2*)(lds + L_VT + offT(k, ig >> 1) + 8 * (ig & 1)) = (u32x2){vtp[0], vtp[1]};
                if (ig == 0) *(LAS float*)(lds + L_DV + k * 4) = __expf(btot);
            }
            __syncthreads();
            const bf16x8 vb = *(const LAS bf16x8*)(lds + L_VT + offT(16 * wv + l15, g));
            f32x4 o = (f32x4){0.f, 0.f, 0.f, 0.f};
            if (PASS == 3) {
                f32x4 att = (f32x4){0.f, 0.f, 0.f, 0.f};
#pragma unroll
                for (int kk = 0; kk < 4; ++kk) {
                    const bf16x8 a = *(const LAS bf16x8*)(lds + L_QT + off16(l15, 4 * kk + g));
                    const bf16x8 bb = *(const LAS bf16x8*)(lds + L_KT + off16(l15, 4 * kk + g));
                    att = __builtin_amdgcn_mfma_f32_16x16x32_bf16(a, bb, att, 0, 0, 0);
                }
                ldsp_t al_ = lds + L_ATT + wv * 1024;
#pragma unroll
                for (int r = 0; r < 4; ++r) { const int t = 4 * g + r; const float v = (l15 <= t) ? att[r] : 0.f; *(LAS bf16_t*)(al_ + t * 64 + l15 * 2) = f2bf(v); }
#pragma unroll
                for (int kk = 0; kk < 4; ++kk) {
                    const u32x2 q0 = *(const LAS u32x2*)(lds + L_QT + off16(l15, 4 * kk + (g >> 1)) + 8 * (g & 1));
                    const u32x2 q1 = *(const LAS u32x2*)(lds + L_QT + off16(l15, 4 * kk + 2 + (g >> 1)) + 8 * (g & 1));
                    const u32x4 aw = (u32x4){q0.x, q0.y, q1.x, q1.y};
                    const u32x4 sw = (u32x4){pk_bf16(S[2 * kk][0], S[2 * kk][1]), pk_bf16(S[2 * kk][2], S[2 * kk][3]), pk_bf16(S[2 * kk + 1][0], S[2 * kk + 1][1]), pk_bf16(S[2 * kk + 1][2], S[2 * kk + 1][3])};
                    o = __builtin_amdgcn_mfma_f32_16x16x32_bf16(__builtin_bit_cast(bf16x8, aw), __builtin_bit_cast(bf16x8, sw), o, 0, 0, 0);
                }
                const bf16x8 aa = *(const LAS bf16x8*)(al_ + l15 * 64 + g * 16);
                o = __builtin_amdgcn_mfma_f32_16x16x32_bf16(aa, vb, o, 0, 0, 0);
            }
#pragma unroll
            for (int mb = 0; mb < 8; ++mb) {
                const f32x4 dv = *(const LAS f32x4*)(lds + L_DV + (16 * mb + 4 * g) * 4);
                const bf16x8 a = *(const LAS bf16x8*)(lds + L_KHT + offT(16 * mb + l15, g));
                S[mb] = __builtin_amdgcn_mfma_f32_16x16x32_bf16(a, vb, S[mb] * dv, 0, 0, 0);
            }
            {
                ldsp_t rn = lds + L_RAW + ((mc + 1) & 1) * 12288;
                *(LAS u32x2*)(rn + rawo) = rl; *(LAS u32x2*)(rn + 4096 + rawo) = rv; if (PASS == 3) *(LAS u32x2*)(rn + 8192 + rawo) = rq;
                if (mc + 2 < HSEGL / 16) { const unsigned go = goff0 + (unsigned)(mc + 2) * 16 * 1024;
                    rl = *(const u32x2*)(lfb + go); rv = *(const u32x2*)(vbp + go); if (PASS == 3) rq = *(const u32x2*)(qbp + go); }
            }
            if (PASS == 3) {
#pragma unroll
                for (int r = 0; r < 4; ++r) { float q = o[r] * o[r]; q += DPPF(q, 0xB1); q += DPPF(q, 0x4E); q += DPPF(q, 0x141); q += DPPF(q, 0x140);
                    if (l15 == 0) *(LAS float*)(lds + L_SSQ + ((4 * g + r) * 8 + wv) * 4) = q; }
            }
            __syncthreads();
            if (PASS == 3) {
#pragma unroll
                for (int r = 0; r < 4; ++r) {
                    const int t = 4 * g + r;
                    const f32x4 s0 = *(const LAS f32x4*)(lds + L_SSQ + t * 32), s1 = *(const LAS f32x4*)(lds + L_SSQ + t * 32 + 16);
                    const float tot = ((s0[0] + s0[1]) + (s0[2] + s0[3])) + ((s1[0] + s1[1]) + (s1[2] + s1[3]));
                    const float rstd = rsqrtf(tot * (1.0f / 128.0f) + LN_EPS);
                    const size_t gi = (tb + t) * 1024 + cbase + 16 * wv + l15;
                    ((unsigned char*)OB)[(tb + t) * 3072 + 2048 + cbase + 16 * wv + l15] = f2fp8(o[r] * rstd * gn * bf2f(gq[r]) * OSCALE);
                }
            }
        }
        if (PASS == 1) {
            float* Lp = HST + ((size_t)s * 512 + tid) * 32;
#pragma unroll
            for (int mb = 0; mb < 8; ++mb) *(f32x4*)(Lp + 4 * mb) = S[mb];
            if (ig == 0) HDEC[(size_t)s * 128 + k] = __expf(lfsum);
        }
        __syncthreads();
    }
}
}
__device__ __forceinline__ void ph_ln1(const Params& p, ldsp_t lds) {
    const float* mod = (const float*)(p.ws + O_MOD);
    bf16_t* h2 = (bf16_t*)(p.ws + O_H2); const bf16_t* r16 = (const bf16_t*)(p.ws + O_R16); unsigned char* h28 = p.ws + O_H28; bf16_t* t16 = (bf16_t*)(p.ws + O_T16);
    const int tid_ = opaque_tid(); const int lane = tid_ & 63, wv = tid_ >> 6;
    const bool bmap = gridDim.x == 256;
    const int row0 = bmap ? ((int)(blockIdx.x & 3) * SEQ + (int)(blockIdx.x >> 2) * 8 + wv) : (int)blockIdx.x * 8 + wv;
    const int rstride = bmap ? 512 : (int)gridDim.x * 8, rend = bmap ? ((int)(blockIdx.x & 3) + 1) * SEQ : NT;
    LAS float* pg = (LAS float*)lds; LAS float* pb = pg + 2048; LAS float* psh = pg + 4096; LAS float* psc = pg + 6144;
    __syncthreads();
    for (int i = tid_; i < 2048; i += NTHREADS) { pg[i] = p.ln1g[i]; pb[i] = p.ln1b[i]; }
    if (bmap) { const int b = blockIdx.x & 3; for (int i = tid_; i < 2048; i += NTHREADS) { psh[i] = mod[b * 12288 + 3 * 2048 + i]; psc[i] = mod[b * 12288 + 4 * 2048 + i] + 1.0f; } }
    else { for (int i = tid_; i < 4 * 2048; i += NTHREADS) { const int b = i >> 11, c = i & 2047; psh[8192 + b * 4096 + c] = mod[b * 12288 + 3 * 2048 + c]; psh[8192 + b * 4096 + 2048 + c] = mod[b * 12288 + 4 * 2048 + c] + 1.0f; } }
    __syncthreads();
    u32x4 gn[4];
    if (row0 < rend) {
#pragma unroll
        for (int i = 0; i < 4; ++i) gn[i] = *(const u32x4*)(r16 + (size_t)row0 * 2048 + (i * 64 + lane) * 8);
    }
#pragma unroll 1
    for (int row = row0; row < rend; row += rstride) {
        const LAS float* sh = bmap ? psh : psh + 8192 + (row >> 13) * 4096; const LAS float* sc = bmap ? psc : sh + 2048;
        f32x4 v[8]; float s = 0.f;
#pragma unroll
        for (int i = 0; i < 4; ++i) {
            const u32x4 g = gn[i];
            v[2 * i] = (f32x4){__uint_as_float(g.x << 16), __uint_as_float(g.x & 0xffff0000u), __uint_as_float(g.y << 16), __uint_as_float(g.y & 0xffff0000u)};
            v[2 * i + 1] = (f32x4){__uint_as_float(g.z << 16), __uint_as_float(g.z & 0xffff0000u), __uint_as_float(g.w << 16), __uint_as_float(g.w & 0xffff0000u)};
        }
        { const int rn = (row + rstride < rend) ? row + rstride : row;
#pragma unroll
          for (int i = 0; i < 4; ++i) gn[i] = *(const u32x4*)(r16 + (size_t)rn * 2048 + (i * 64 + lane) * 8); }
#pragma unroll
        for (int i = 0; i < 8; ++i) s += (v[i][0] + v[i][1]) + (v[i][2] + v[i][3]);
        float mu = wave_sum(s) * (1.0f / 2048.0f);
        float q = 0.f;
#pragma unroll
        for (int i = 0; i < 8; ++i) { v[i] -= mu; q += (v[i][0] * v[i][0] + v[i][1] * v[i][1]) + (v[i][2] * v[i][2] + v[i][3] * v[i][3]); }
        float rstd = rsqrtf(wave_sum(q) * (1.0f / 2048.0f) + LN_EPS);
        s = 0.f;
#pragma unroll
        for (int i = 0; i < 8; ++i) {
            const int col = ((i >> 1) * 64 + lane) * 8 + (i & 1) * 4;
            v[i] = v[i] * rstd * *(const LAS f32x4*)(pg + col) + *(const LAS f32x4*)(pb + col);
            s += (v[i][0] + v[i][1]) + (v[i][2] + v[i][3]);
        }
#pragma unroll
        for (int i = 0; i < 4; ++i) st8_bf16(t16 + (size_t)row * 2048 + (i * 64 + lane) * 8, v[2 * i], v[2 * i + 1]);
        mu = wave_sum(s) * (1.0f / 2048.0f); q = 0.f;
#pragma unroll
        for (int i = 0; i < 8; ++i) { v[i] -= mu; q += (v[i][0] * v[i][0] + v[i][1] * v[i][1]) + (v[i][2] * v[i][2] + v[i][3] * v[i][3]); }
        rstd = rsqrtf(wave_sum(q) * (1.0f / 2048.0f) + LN_EPS);
#pragma unroll
        for (int i = 0; i < 4; ++i) {
            const int col = (i * 64 + lane) * 8;
            const f32x4 sh0 = *(const LAS f32x4*)(sh + col), sh1 = *(const LAS f32x4*)(sh + col + 4);
            const f32x4 sc0 = *(const LAS f32x4*)(sc + col), sc1 = *(const LAS f32x4*)(sc + col + 4);
            const f32x4 y0 = v[2 * i] * rstd * sc0 + sh0, y1 = v[2 * i + 1] * rstd * sc1 + sh1;
            st8_bf16(h2 + (size_t)row * 2048 + col, y0, y1);
            *(u32x2*)(h28 + (size_t)row * 2048 + col) = pk8_fp8(y0, y1);
        }
    }
    __syncthreads();
}

__device__ __forceinline__ void route_block(const Params& p, ldsp_t lds, const int t0, const int nt) {
    const float* logit = (const float*)(p.ws + O_LOGIT);
    int* rsel = (int*)(p.ws + O_RSEL); float* rw = (float*)(p.ws + O_RW); int* cnt = (int*)(p.ws + O_CNT);
    LAS float* sb = (LAS float*)lds;
    LAS int* hist = (LAS int*)(lds + 512 * 65 * 4);
    const int tid = opaque_tid();
    const bool act = tid < nt;
    const int tok = t0 + (act ? tid : 0), chunk = t0 / CHTOK;
    __syncthreads();
    if (tid < 64) hist[tid] = 0;
    LAS float* my = sb + tid * 65;
    if (act) {
#pragma unroll 4
        for (int e = 0; e < 64; e += 4) { const f32x4 l = *(const f32x4*)(logit + (size_t)tok * 64 + e);
#pragma unroll
            for (int j = 0; j < 4; ++j) my[e + j] = sigmoidf_(l[j]) + p.rbias[e + j]; }
    }
    __syncthreads();
    if (act) {
        float gs[8];
#pragma unroll
        for (int gI = 0; gI < 8; ++gI) { float m1 = -1e30f, m2 = -1e30f;
#pragma unroll
            for (int j = 0; j < 8; ++j) { const float v = my[gI * 8 + j]; if (v > m1) { m2 = m1; m1 = v; } else if (v > m2) m2 = v; }
            gs[gI] = m1 + m2; }
        unsigned gmask = 0;
#pragma unroll
        for (int r = 0; r < 4; ++r) { float best = -1e30f; int bi = 0;
#pragma unroll
            for (int gI = 0; gI < 8; ++gI) { const bool ok = !((gmask >> gI) & 1u) && gs[gI] > best; if (ok) { best = gs[gI]; bi = gI; } }
            gmask |= 1u << bi; }
        int se[8]; float sw[8]; float wsum = 0.f;
        unsigned long long taken = 0ull;
#pragma unroll
        for (int r = 0; r < 8; ++r) { float best = -1e30f; int bi = 0;
            for (int e = 0; e < 64; ++e) { const bool ok = ((gmask >> (e >> 3)) & 1u) && !((taken >> e) & 1ull); const float v = my[e]; if (ok && v > best) { best = v; bi = e; } }
            taken |= 1ull << bi; se[r] = bi; const float sc = my[bi] - p.rbias[bi]; sw[r] = sc; wsum += sc; }
        const float inv = 2.5f / wsum;
#pragma unroll
        for (int r = 0; r < 8; ++r) { rsel[(size_t)tok * 8 + r] = se[r]; rw[(size_t)tok * 8 + r] = sw[r] * inv; atomicAdd((int*)&hist[se[r]], 1); }
    }
    __syncthreads();
    if (tid < 64) atomicAdd(&cnt[chunk * 256 + tid], hist[tid]);
}
__device__ __forceinline__ void ph_route(const Params& p, ldsp_t lds) {
    for (int t0 = blockIdx.x * NTHREADS; t0 < NT; t0 += gridDim.x * NTHREADS) route_block(p, lds, t0, NTHREADS);
    __syncthreads();
}
__device__ __forceinline__ void ph_slots(const Params& p, ldsp_t lds) {
    const int* rsel = (const int*)(p.ws + O_RSEL); const float* rw = (const float*)(p.ws + O_RW); int* cnt = (int*)(p.ws + O_CNT);
    int* tstart = (int*)(p.ws + O_TSTART); int* tilee = (int*)(p.ws + O_TILEE);
    int* tokof = (int*)(p.ws + O_TOKOF); u32x2* wd = (u32x2*)(p.ws + O_WOF);
    LAS int* ts = (LAS int*)lds;
    const int tid = opaque_tid();
    __syncthreads();
    if (tid < NCHUNK) { int acc = 0; for (int e = 0; e < 64; ++e) { ts[tid * 66 + e] = acc; acc += (cnt[tid * 256 + e] + 255) >> 8; } ts[tid * 66 + 64] = acc; ts[tid * 66 + 65] = acc + CHTOK / 256; }
    __syncthreads();
    if (blockIdx.x == 0) {
        for (int i = tid; i < NCHUNK * 66; i += NTHREADS) tstart[(i / 66) * 128 + (i % 66)] = ts[i];
        for (int i = tid; i < NCHUNK * MAXTILES; i += NTHREADS) { const int c = i / MAXTILES, t = i % MAXTILES; int e = 0; for (int q = 0; q < 65; ++q) if (t >= ts[c * 66 + q]) e = q; tilee[c * MAXTILES + t] = e; }
    }
    for (int tok = blockIdx.x * NTHREADS + tid; tok < NT; tok += gridDim.x * NTHREADS) {
        const int c = tok / CHTOK, tl = tok % CHTOK;
#pragma unroll
        for (int r = 0; r < 8; ++r) {
            const int e = rsel[(size_t)tok * 8 + r];
            const int rank = atomicAdd(&cnt[c * 256 + 128 + e], 1);
            const int slot = ts[c * 66 + e] * 256 + rank;
            tokof[c * MAXSLOTS + slot] = tok; wd[c * MAXSLOTS + slot] = (u32x2){__float_as_uint(rw[(size_t)tok * 8 + r]), (unsigned)(tl * 8 + r)};
        }
        const int slot = ts[c * 66 + 64] * 256 + tl;
        tokof[c * MAXSLOTS + slot] = tok; wd[c * MAXSLOTS + slot] = (u32x2){__float_as_uint(1.0f), (unsigned)tok};
    }
    for (int i = blockIdx.x * NTHREADS + tid; i < NCHUNK * 64 * 256; i += gridDim.x * NTHREADS) {
        const int c = i >> 14, e = (i >> 8) & 63, j = i & 255;
        const int n = cnt[c * 256 + e], pad = ((n + 255) & ~255) - n;
        if (j < pad) { const int slot = ts[c * 66 + e] * 256 + n + j; tokof[c * MAXSLOTS + slot] = c * CHTOK; wd[c * MAXSLOTS + slot] = (u32x2){0u, 0xffffffffu}; }
    }
    __syncthreads();
}
__device__ __forceinline__ int exp1_units_of(int wg, int ntiles, int G) {
    if (G == 256) { const int rem = ntiles - 8 * (wg & 7) - ((wg >> 3) & 7); return rem > 0 ? (rem + 63) >> 6 : 0; }
    const int tot = ntiles * 4; return tot > wg ? (tot - wg + G - 1) / G : 0;
}
__device__ __forceinline__ void ph_combine(const Params& p, ldsp_t lds, int chunk) {
    const float* mod = (const float*)(p.ws + O_MOD); const unsigned char* Y = p.ws + O_Y; const bf16_t* t16 = (const bf16_t*)(p.ws + O_H2);
    const int tid_ = opaque_tid(); const int lane0 = tid_ & 63, wv = tid_ >> 6;
    LAS float* pg2 = (LAS float*)lds; LAS float* pg = pg2 + (CHTOK / SEQ) * 2048; LAS float* pb = pg + 2048;
    __syncthreads();
    for (int i = tid_; i < (CHTOK / SEQ) * 2048; i += NTHREADS) pg2[i] = mod[(chunk * (CHTOK / SEQ) + (i >> 11)) * 12288 + 5 * 2048 + (i & 2047)] * (1.0f / YSCALE);
    for (int i = tid_; i < 2048; i += NTHREADS) { pg[i] = p.ln2g[i]; pb[i] = p.ln2b[i]; }
    __syncthreads();
#pragma unroll 1
    for (int tl = blockIdx.x * 8 + wv; tl < CHTOK; tl += gridDim.x * 8) {
        const int row = chunk * CHTOK + tl;
        const LAS float* g2p = pg2 + (tl >> 13) * 2048;
        int lane = lane0; asm volatile("" : "+v"(lane));
        float* xr = p.out + (size_t)row * 2048;
        f32x4 a[8];
        u32x4 tq[4];
#pragma unroll
        for (int i2 = 0; i2 < 2; ++i2) { const int sp = (i2 * 64 + lane) * 16; const int ub = (sp & ~255) + ((sp & 255) >> 6) * 32 + ((sp & 63) >> 4) * 8;
            tq[2 * i2] = *(const u32x4*)(t16 + (size_t)row * 2048 + ub); tq[2 * i2 + 1] = *(const u32x4*)(t16 + (size_t)row * 2048 + ub + 128); }
#pragma unroll
        for (int i = 0; i < 8; ++i) a[i] = (f32x4){0.f, 0.f, 0.f, 0.f};
#pragma unroll 4
        for (int j = 0; j < 8; ++j) {
            const unsigned char* yr = Y + ((size_t)tl * 8 + j) * 2048;
#pragma unroll
            for (int i = 0; i < 2; ++i) {
                const u32x4 g = *(const u32x4*)(yr + (i * 64 + lane) * 16);
#pragma unroll
                for (int qd = 0; qd < 4; ++qd) {
                    const f32x2 lo = __builtin_amdgcn_cvt_pk_f32_fp8((int)g[qd], false), hi = __builtin_amdgcn_cvt_pk_f32_fp8((int)g[qd], true);
                    a[4 * i + qd][0] += lo[0]; a[4 * i + qd][1] += lo[1]; a[4 * i + qd][2] += hi[0]; a[4 * i + qd][3] += hi[1];
                }
            }
        }
        float s = 0.f;
#pragma unroll
        for (int i = 0; i < 8; ++i) {
            const int sp = ((i >> 2) * 64 + lane) * 16;
            const int col = (sp & ~255) + ((sp & 255) >> 6) * 32 + ((sp & 63) >> 4) * 8 + ((i & 3) >> 1) * 128 + (i & 1) * 4;
            const f32x4 g2 = *(const LAS f32x4*)(g2p + col);
            const u32x4 t4 = tq[(i >> 2) * 2 + ((i & 3) >> 1)]; const u32x2 tt = (i & 1) ? (u32x2){t4.z, t4.w} : (u32x2){t4.x, t4.y};
            a[i] = (f32x4){__uint_as_float(tt.x << 16), __uint_as_float(tt.x & 0xffff0000u), __uint_as_float(tt.y << 16), __uint_as_float(tt.y & 0xffff0000u)} + g2 * a[i];
            s += (a[i][0] + a[i][1]) + (a[i][2] + a[i][3]);
        }
        const float mu = wave_sum(s) * (1.0f / 2048.0f);
        float q = 0.f;
#pragma unroll
        for (int i = 0; i < 8; ++i) { a[i] -= mu; q += (a[i][0] * a[i][0] + a[i][1] * a[i][1]) + (a[i][2] * a[i][2] + a[i][3] * a[i][3]); }
        const float rstd = rsqrtf(wave_sum(q) * (1.0f / 2048.0f) + LN_EPS);
#pragma unroll
        for (int i = 0; i < 8; ++i) {
            const int sp = ((i >> 2) * 64 + lane) * 16;
            const int col = (sp & ~255) + ((sp & 255) >> 6) * 32 + ((sp & 63) >> 4) * 8 + ((i & 3) >> 1) * 128 + (i & 1) * 4;
            *(f32x4*)(xr + col) = a[i] * rstd * *(const LAS f32x4*)(pg + col) + *(const LAS f32x4*)(pb + col);
        }
    }
    __syncthreads();
}
#ifndef PROBE
#define PROBE 0
#endif
#define REP(n) for (int rep_ = 0; rep_ < p.rep[n]; ++rep_)
#define GBAR do { xcd_barrier(bar); for (int xr_ = 0; xr_ < p.rep[1]; ++xr_) xcd_barrier(bar); } while (0)
__global__ __launch_bounds__(512, 2) void mega(Params p) {
    extern __shared__ __attribute__((aligned(16))) unsigned char shm_[];
    ldsp_t lds = (ldsp_t)shm_;
    volatile LAS unsigned* st = (volatile LAS unsigned*)(lds + LDS_BYTES - 16);
    if (threadIdx.x == 0) { st[0] = 0u; st[1] = 0u; st[2] = 0u; st[3] = 0u; }
    __syncthreads();
    XcdBarrier bar = xcd_barrier_post((unsigned*)(p.ws + O_BAR), st);
    unsigned char* ws = p.ws;
    _Pragma("unroll 1") REP(8) { ph_conv_small(p, lds); ph_mod(p, lds);
    GBAR;
    ph_lnmod(p, lds);
    GBAR; }
    _Pragma("unroll 1") REP(12) { EpiInProj<false> e; e.ws = ws; gm::gemm_phase(lds, dense<3>(ws + O_HN, 2048, ws + O_BTIN, 2048), e, 2048); }
    _Pragma("unroll 1") REP(19) { EpiInProj<true> e; e.ws = ws; gm::gemm_phase(lds, dense<32>(ws + O_H8, 1024, ws + O_BTIN8, 1024), e, 1024); }
    GBAR;
    _Pragma("unroll 1") REP(9) { ph_smallnorm(p); hg::run<1>(p, lds); }
    GBAR;
    _Pragma("unroll 1") REP(11) { EpiQ e; e.ws = ws; gm::gemm_phase(lds, dense<12>(ws + O_CQN, 512, ws + O_BTQ, 512), e, 512); }
    GBAR;
    _Pragma("unroll 1") REP(2) ph_indexer(p, lds, rep_ == 0 ? 1 : p.rep[13]);
    GBAR;
    _Pragma("unroll 1") REP(3) ph_attn(p, lds);
    _Pragma("unroll 1") REP(6) hg::run<3>(p, lds);
    GBAR;
    {
    _Pragma("unroll 1") REP(7) { EpiMergeA e; e.ws = ws; e.m1 = (bf16_t*)p.out; gm::gemm_phase(lds, dense<8>(ws + O_OLAT, 1536, ws + O_BTAB, 1536), e, 1024); }
    _Pragma("unroll 1") REP(14) { EpiMergeB e; e.ws = ws; e.m1 = (const bf16_t*)p.out; gm::gemm_phase(lds, dense<8>(ws + O_OLAT + 2048, 1536, ws + O_BTAB + 2048, 1536), e, 512); }
    GBAR;
    _Pragma("unroll 1") REP(15) { EpiWo e; e.x = p.x; e.mod = (const float*)(ws + O_MOD); e.r = (bf16_t*)(ws + O_R16); gm::gemm_phase(lds, dense<8>(ws + O_MIX, 1024, ws + O_BTO, 1024), e, 1024); }
    GBAR; }
    _Pragma("unroll 1") REP(16) ph_ln1(p, lds);
    GBAR;
    {
    _Pragma("unroll 1") REP(10) { EpiRouter e; e.logit = (float*)(ws + O_LOGIT); gm::gemm_phase(lds, dense<1>(ws + O_H2, 2048, ws + O_BTR, 2048), e, 2048); }
    const bool fused_route = gridDim.x == 256;
    if (fused_route && blockIdx.x < 128) { asm volatile("s_waitcnt vmcnt(0)" ::: "memory"); __syncthreads();
        route_block(p, lds, (((int)blockIdx.x & 7) * 16 + ((int)blockIdx.x >> 3)) * 256, 256); __syncthreads(); }
    _Pragma("unroll 1") REP(17) ph_conv_experts(p, lds);
    GBAR; }
    if (gridDim.x != 256) { ph_route(p, lds);
    GBAR; }
    ph_slots(p, lds);
    GBAR;
#pragma unroll 1
    for (int c = 0; c < NCHUNK; ++c) {
        const int ntiles = c < 4 ? ((const int*)(ws + O_TSTART))[c * 128 + 65] : 0;
        if (c < 4) { _Pragma("unroll 1") REP(4) { Exp1Sched s; s.h2 = (const char*)(ws + O_H28); s.btgu = (const char*)(ws + O_BTGU); s.tokof = (const int*)(ws + O_TOKOF) + c * MAXSLOTS; s.tilee = (const int*)(ws + O_TILEE) + c * MAXTILES;
          s.ntiles = ntiles; s.G = gridDim.x; s.c = blockIdx.x; s.lda = 1024; s.ldb = 1024;
          EpiExp1 e; e.hh = ws + O_HH; gm::gemm_phase(lds, s, e, 1024); } }
        if (c < 4) {
        GBAR;
        _Pragma("unroll 1") REP(5) { Exp2Sched s; s.hh = (const char*)(ws + O_HH); s.btd = (const char*)(ws + O_BTD); s.tilee = (const int*)(ws + O_TILEE) + c * MAXTILES;
          s.ntiles = ntiles; s.G = gridDim.x; s.c = blockIdx.x; s.lda = 256; s.ldb = 256;
          EpiExp2 e; e.y = ws + O_Y; e.wd = (const u32x2*)(ws + O_WOF) + c * MAXSLOTS; e.t16 = (const bf16_t*)(ws + O_T16); e.t16o = (bf16_t*)(ws + O_H2); e.mod = (const float*)(ws + O_MOD); gm::gemm_phase(lds, s, e, 256); }
        GBAR;
        _Pragma("unroll 1") REP(18) ph_combine(p, lds, c);
        }
    }
}

extern "C" void kernel_launch(void* const* d_in, const int* in_sizes, int n_in, void* d_out, int out_size, void* d_ws, size_t ws_size, hipStream_t stream) {
    (void)in_sizes; (void)n_in; (void)out_size; (void)ws_size;
    Params p; memset(&p, 0, sizeof(p));
    const float** f = (const float**)&p;
    for (int i = 0; i < 31; ++i) f[i] = (const float*)d_in[i];
    p.out = (float*)d_out; p.ws = (unsigned char*)d_ws;
    for (int i = 0; i < 20; ++i) p.rep[i] = 1;
    p.rep[1] = 0;
    if (PROBE > 0 && PROBE < 20) p.rep[PROBE] = 2;
    if (PROBE == 13) { p.rep[2] = 2; p.rep[13] = 0; }
    static int grid = 0;
    if (!grid) {
        int dev = 0, cus = 0, per_cu = 0;
        (void)hipGetDevice(&dev);
        (void)hipDeviceGetAttribute(&cus, hipDeviceAttributeMultiprocessorCount, dev);
        (void)hipFuncSetAttribute((const void*)mega, hipFuncAttributeMaxDynamicSharedMemorySize, LDS_BYTES);
        (void)hipOccupancyMaxActiveBlocksPerMultiprocessor(&per_cu, mega, 512, LDS_BYTES);
        if (per_cu < 1) per_cu = 1;
        grid = cus * 1;
        if (grid > 256) grid = 256;
    }
    (void)hipMemsetAsync(d_ws, 0, O_ZERO_BYTES, stream);
    hipLaunchKernelGGL(mega, dim3(grid), dim3(512), LDS_BYTES, stream, p);
}
```
